# Optimizing an MI355X kernel written in HIP

```python
import jax, jax.numpy as jnp
from jax import lax
import numpy as np

D_MODEL = 2048
BATCH = 4
SEQ = 4096
DEPTH = 1

MLA_HEADS = 8
QK_NOPE_DIM = 128
QK_ROPE_DIM = 64
V_HEAD_DIM = 128
Q_LORA_RANK = 512
KV_LORA_RANK = 256
ROPE_THETA = 10000.0
Q_BLOCK = 128
DIL_PATTERNS = ((128, 1), (512, 4), (2048, 16))
DIL_GROUPS = 3
DIL_HEADS_PER_GROUP = 4
DIL_HEADS = DIL_GROUPS * DIL_HEADS_PER_GROUP
DIL_HEAD_DIM = 128
DIL_BLOCK = 128
ALIBI_MAX_BIAS = 8.0
D_FF = 5504
CONV_WIDTH = 3
NORM_EPS = 1e-6

MLA_Q_DIM = MLA_HEADS * (QK_NOPE_DIM + QK_ROPE_DIM)
MLA_KV_DIM = MLA_HEADS * (QK_NOPE_DIM + V_HEAD_DIM)
DIL_QKV_DIM = DIL_HEADS * DIL_HEAD_DIM
DIL_OUT_DIM = DIL_HEADS_PER_GROUP * DIL_HEAD_DIM
IN_SPLITS = (Q_LORA_RANK, KV_LORA_RANK, QK_ROPE_DIM, DIL_QKV_DIM, DIL_QKV_DIM, DIL_QKV_DIM, D_MODEL, D_MODEL)
D_IN = Q_LORA_RANK + KV_LORA_RANK + QK_ROPE_DIM + 3 * DIL_QKV_DIM + 2 * D_MODEL

kernel_name = 'hybrid_mla_dilated_convffn'


def rmsnorm(x, g):
    xf = x.astype(jnp.float32)
    y = xf * lax.rsqrt(jnp.mean(xf * xf, axis=-1, keepdims=True) + NORM_EPS)
    return (y * g.astype(jnp.float32)).astype(x.dtype)


def rope(x, cos, sin):
    half = x.shape[-1] // 2
    xf = x.astype(jnp.float32)
    x1, x2 = xf[..., :half], xf[..., half:]
    return jnp.concatenate([x1 * cos - x2 * sin, x2 * cos + x1 * sin], axis=-1).astype(x.dtype)


def mla_attention(c_q, c_kv, k_pe_raw, q_norm_g, w_uq, kv_norm_g, w_ukv):
    B, S, _ = c_q.shape
    q = (rmsnorm(c_q, q_norm_g) @ w_uq).reshape(B, S, MLA_HEADS, QK_NOPE_DIM + QK_ROPE_DIM)
    kv = (rmsnorm(c_kv, kv_norm_g) @ w_ukv).reshape(B, S, MLA_HEADS, QK_NOPE_DIM + V_HEAD_DIM)
    q_nope, q_pe = q[..., :QK_NOPE_DIM], q[..., QK_NOPE_DIM:]
    k_nope, v = kv[..., :QK_NOPE_DIM], kv[..., QK_NOPE_DIM:]
    pos = jnp.arange(S, dtype=jnp.float32)
    inv_freq = ROPE_THETA ** (-jnp.arange(0, QK_ROPE_DIM, 2, dtype=jnp.float32) / QK_ROPE_DIM)
    ang = pos[:, None] * inv_freq[None, :]
    cos, sin = jnp.cos(ang), jnp.sin(ang)
    q_pe = rope(q_pe, cos[:, None, :], sin[:, None, :])
    k_pe = rope(k_pe_raw, cos, sin)
    scale = (QK_NOPE_DIM + QK_ROPE_DIM) ** -0.5
    nb = S // Q_BLOCK
    qn_b = q_nope.reshape(B, nb, Q_BLOCK, MLA_HEADS, QK_NOPE_DIM).transpose(1, 0, 2, 3, 4)
    qp_b = q_pe.reshape(B, nb, Q_BLOCK, MLA_HEADS, QK_ROPE_DIM).transpose(1, 0, 2, 3, 4)
    kpos = jnp.arange(S)

    def one_block(args):
        qn, qp, i = args
        s = (jnp.einsum('bqhd,bkhd->bhqk', qn, k_nope).astype(jnp.float32)
             + jnp.einsum('bqhr,bkr->bhqk', qp, k_pe).astype(jnp.float32)) * scale
        qpos = i * Q_BLOCK + jnp.arange(Q_BLOCK)
        s = jnp.where(kpos[None, :] <= qpos[:, None], s, -jnp.inf)
        p = jax.nn.softmax(s, axis=-1).astype(v.dtype)
        return jnp.einsum('bhqk,bkhd->bqhd', p, v)

    o = lax.map(one_block, (qn_b, qp_b, jnp.arange(nb)))
    return o.transpose(1, 0, 2, 3, 4).reshape(B, S, MLA_HEADS * V_HEAD_DIM)


def dilated_group(q, k, v, window, dil, slopes):
    B, S, H, D = q.shape
    w_sub = window // dil
    L = S // dil
    nb = -(-L // DIL_BLOCK)
    Lp = nb * DIL_BLOCK

    def to_blocks(t):
        t = t.reshape(B, L, dil, H, D).transpose(0, 2, 1, 3, 4)
        t = jnp.pad(t, ((0, 0), (0, 0), (0, Lp - L), (0, 0), (0, 0)))
        return t.reshape(B, dil, nb, DIL_BLOCK, H, D)

    def with_prev(t):
        prev = jnp.pad(t, ((0, 0), (0, 0), (1, 0), (0, 0), (0, 0), (0, 0)))[:, :, :-1]
        return jnp.concatenate([prev, t], axis=3)

    qb = to_blocks(q)
    kk = with_prev(to_blocks(k))
    vv = with_prev(to_blocks(v))
    s = jnp.einsum('brnqhd,brnkhd->brnhqk', qb, kk).astype(jnp.float32) * (D ** -0.5)
    p_idx = jnp.arange(DIL_BLOCK)
    k_idx = jnp.arange(2 * DIL_BLOCK)
    j = p_idx[:, None] + DIL_BLOCK - k_idx[None, :]
    valid = (j >= 0) & (j <= w_sub)
    first = jnp.arange(nb) == 0
    valid = valid[None] & ~(first[:, None, None] & (k_idx < DIL_BLOCK)[None, None, :])
    alibi = -slopes.astype(jnp.float32)[:, None, None] * (dil * j).astype(jnp.float32)[None]
    s = jnp.where(valid[None, None, :, None], s + alibi[None, None, None], -jnp.inf)
    lse = jax.nn.logsumexp(s, axis=-1)
    p = jnp.exp(s - lse[..., None]).astype(v.dtype)
    o = jnp.einsum('brnhqk,brnkhd->brnqhd', p, vv)

    def from_blocks(t):
        t = t.reshape((B, dil, Lp) + t.shape[4:])[:, :, :L]
        t = jnp.moveaxis(t, 1, 2)
        return t.reshape((B, S) + t.shape[3:])

    return from_blocks(o), from_blocks(lse.transpose(0, 1, 2, 4, 3))


def dilated_attention(dq, dk, dv):
    B, S, _ = dq.shape
    shp = (B, S, DIL_GROUPS, DIL_HEADS_PER_GROUP, DIL_HEAD_DIM)
    q, k, v = dq.reshape(shp), dk.reshape(shp), dv.reshape(shp)
    slopes = 2.0 ** (-ALIBI_MAX_BIAS * jnp.arange(1, DIL_HEADS + 1, dtype=jnp.float32) / DIL_HEADS)
    slopes = slopes.reshape(DIL_GROUPS, DIL_HEADS_PER_GROUP)
    outs, lses = [], []
    for g, (window, dil) in enumerate(DIL_PATTERNS):
        o_g, l_g = dilated_group(q[:, :, g], k[:, :, g], v[:, :, g], window, dil, slopes[g])
        outs.append(o_g)
        lses.append(l_g)
    o = jnp.stack(outs, axis=0)
    wts = jax.nn.softmax(jnp.stack(lses, axis=0), axis=0)
    out = jnp.sum(wts[..., None] * o.astype(jnp.float32), axis=0).astype(dq.dtype)
    return out.reshape(B, S, DIL_OUT_DIM)


def causal_dwconv(u, w, b):
    S = u.shape[1]
    upad = jnp.pad(u, ((0, 0), (CONV_WIDTH - 1, 0), (0, 0)))
    out = b
    for t in range(CONV_WIDTH):
        out = out + w[t] * upad[:, t:t + S]
    return out


def setup_inputs(seed: int = 0) -> dict:
    key = jax.random.key(seed)
    ks = jax.random.split(key, 17)

    def w(k, shape, fan_in):
        return jax.random.normal(k, shape, jnp.float32) * (fan_in ** -0.5)

    def gain(k, shape):
        return 1.0 + 0.02 * jax.random.normal(k, shape, jnp.float32)

    return {
        'x': jax.random.normal(ks[0], (BATCH, SEQ, D_MODEL), jnp.float32),
        'attn_norm_g': gain(ks[1], (DEPTH, D_MODEL)),
        'w_in': w(ks[2], (DEPTH, D_MODEL, D_IN), D_MODEL),
        'b_gate': 0.02 * jax.random.normal(ks[3], (DEPTH, 2 * D_MODEL), jnp.float32),
        'q_norm_g': gain(ks[4], (DEPTH, Q_LORA_RANK)),
        'w_uq': w(ks[5], (DEPTH, Q_LORA_RANK, MLA_Q_DIM), Q_LORA_RANK),
        'kv_norm_g': gain(ks[6], (DEPTH, KV_LORA_RANK)),
        'w_ukv': w(ks[7], (DEPTH, KV_LORA_RANK, MLA_KV_DIM), KV_LORA_RANK),
        'w_o_mla': w(ks[8], (DEPTH, MLA_HEADS * V_HEAD_DIM, D_MODEL), MLA_HEADS * V_HEAD_DIM),
        'w_o_dil': w(ks[9], (DEPTH, DIL_OUT_DIM, D_MODEL), DIL_OUT_DIM),
        'w_out': w(ks[10], (DEPTH, D_MODEL, D_MODEL), D_MODEL),
        'ffn_norm_g': gain(ks[11], (DEPTH, D_MODEL)),
        'w_up': w(ks[12], (DEPTH, D_MODEL, 2 * D_FF), D_MODEL),
        'conv_w': w(ks[13], (DEPTH, CONV_WIDTH, 2 * D_FF), CONV_WIDTH),
        'conv_b': 0.02 * jax.random.normal(ks[14], (DEPTH, 2 * D_FF), jnp.float32),
        'w_down': w(ks[15], (DEPTH, D_FF, D_MODEL), D_FF),
        'final_norm_g': gain(ks[16], (D_MODEL,)),
    }


def reference(x, attn_norm_g, w_in, b_gate, q_norm_g, w_uq, kv_norm_g, w_ukv, w_o_mla, w_o_dil,
              w_out, ffn_norm_g, w_up, conv_w, conv_b, w_down, final_norm_g):
    split_at = [int(c) for c in np.cumsum(IN_SPLITS)[:-1]]
    for l in range(DEPTH):
        h = rmsnorm(x, attn_norm_g[l])
        proj = h @ w_in[l]
        c_q, c_kv, k_pe, dq, dk, dv, ga, gb = jnp.split(proj, split_at, axis=-1)
        gate_a = jax.nn.sigmoid(ga + b_gate[l, :D_MODEL])
        gate_b = jax.nn.sigmoid(gb + b_gate[l, D_MODEL:])
        o_a = mla_attention(c_q, c_kv, k_pe, q_norm_g[l], w_uq[l], kv_norm_g[l], w_ukv[l]) @ w_o_mla[l]
        o_b = dilated_attention(dq, dk, dv) @ w_o_dil[l]
        x = x + (gate_a * o_a + gate_b * o_b) @ w_out[l]
        h2 = rmsnorm(x, ffn_norm_g[l])
        u = causal_dwconv(h2 @ w_up[l], conv_w[l], conv_b[l])
        up, gate = u[..., :D_FF], u[..., D_FF:]
        x = x + (jax.nn.silu(gate) * up) @ w_down[l]
    return rmsnorm(x, final_norm_g)
```

```cpp
#include <hip/hip_runtime.h>
#include <hip/hip_cooperative_groups.h>
#include <cstdio>
#include <cstdint>
namespace cg = cooperative_groups;
namespace pg8 {
#define PG8_LAS __attribute__((address_space(3)))
typedef unsigned short bf16_t;
typedef short bf16x8 __attribute__((ext_vector_type(8)));
typedef float f32x4 __attribute__((ext_vector_type(4)));
typedef unsigned u32x4 __attribute__((ext_vector_type(4)));
constexpr int BM = 256, BK = 64, HALF = 128, HTB = HALF * BK * 2  , STAGE_BYTES = 8 * HTB, NXCD = 8, WGM = 8;

__host__ __device__ __forceinline__ int lds_byte(int r, int c) { const int st = (r >> 4) * 2 + (c >> 5), rr = r & 15, cc = c & 31, ob = rr * 64 + cc * 2; return st * 1024 + (ob ^ (((ob >> 9) & 1) << 5)); }
__host__ __device__ __forceinline__ void stage_rc(int b, int& R, int& C) { const int st = b / 1024, sb = b % 1024, swz = sb ^ (((sb >> 9) & 1) << 5); R = (st >> 1) * 16 + swz / 64; C = (st & 1) * 32 + (swz % 64) / 2; }
__host__ __device__ __forceinline__ int perm32(int rho) { const int n = rho >> 4, i = rho & 15; return 8 * (i >> 2) + 4 * n + (i & 3); }

struct Unit { int pm, pn; };
struct Gemm { const bf16_t* A; const bf16_t* Bt; int M, N, K; };

struct StaticOrder {
    int nM, nN, nwg, G, c;
    __host__ __device__ void init(int M, int N, int G_, int c_) { nM = M / BM; nN = N / BM; nwg = nM * nN; G = G_; c = c_; }
    __host__ __device__ bool next(int i, Unit& u) const {
        const long L = (long)i * G + c; if (L >= nwg) return false;
        int wgid = (int)L; { const int q = nwg / NXCD, r = nwg % NXCD, xcd = wgid % NXCD, off = wgid / NXCD; wgid = (xcd < r ? xcd * (q + 1) : r * (q + 1) + (xcd - r) * q) + off; }
        const int nig = WGM * nN, gid = wgid / nig, fm = gid * WGM, gsz = (nM - fm) < WGM ? (nM - fm) : WGM;
        u.pm = fm + ((wgid % nig) % gsz); u.pn = (wgid % nig) / gsz; return true;
    }
    __device__ __forceinline__ void a_ready(const Unit&) const {}
    __device__ __forceinline__ void done(const Unit&) const {}
};

__device__ __forceinline__ unsigned cvt_pk_bf16(float lo, float hi) { unsigned r; asm volatile("v_cvt_pk_bf16_f32 %0, %1, %2" : "=v"(r) : "v"(lo), "v"(hi)); return r; }
typedef float f32x2 __attribute__((ext_vector_type(2)));
typedef unsigned u32x2 __attribute__((ext_vector_type(2)));
constexpr float NORM_EPS_F = 1e-6f;
__device__ __forceinline__ float bf_lo(unsigned w) { return __uint_as_float(w << 16); }
__device__ __forceinline__ float bf_hi(unsigned w) { return __uint_as_float(w & 0xffff0000u); }
__device__ __forceinline__ u32x4 pack8(const f32x4 a, const f32x4 b) { u32x4 w; w.x = cvt_pk_bf16(a[0], a[1]); w.y = cvt_pk_bf16(a[2], a[3]); w.z = cvt_pk_bf16(b[0], b[1]); w.w = cvt_pk_bf16(b[2], b[3]); return w; }
__device__ __forceinline__ float sq8(const f32x4 a, const f32x4 b) { return (a[0] * a[0] + a[1] * a[1]) + (a[2] * a[2] + a[3] * a[3]) + (b[0] * b[0] + b[1] * b[1]) + (b[2] * b[2] + b[3] * b[3]); }
__device__ __forceinline__ float sigm(float v) { return 1.0f / (1.0f + __expf(-v)); }

struct EpiProj {
    static constexpr bool PERM = true, AFTER_DRAIN = false;
    bf16_t *CQ, *CKV, *DQ, *DK, *DV, *GA, *GB; float* KPER; const float* rstd0; float *ssq_q, *ssq_kv; const float* b_gate;
    __device__ __forceinline__ void operator()(const f32x4 (&acc)[2][2][4][2], const Unit& u, int wr, int wc, int fr, int fq) const {
        const int pn = u.pn; const int row0 = u.pm * BM + wr * 64 + fr; const int cw = wc * 32 + 8 * fq;
        bf16_t* base = CQ; int ldc = 512, c0 = 0; const float* bias = nullptr; float* ssq = nullptr;
        if (pn < 2) { base = CQ; ldc = 512; c0 = pn * 256; ssq = ssq_q; }
        else if (pn == 2) { base = CKV; ldc = 256; c0 = 0; ssq = ssq_kv; }
        else if (pn == 3) { base = nullptr; }
        else if (pn < 10) { base = DQ; ldc = 1536; c0 = (pn - 4) * 256; }
        else if (pn < 16) { base = DK; ldc = 1536; c0 = (pn - 10) * 256; }
        else if (pn < 22) { base = DV; ldc = 1536; c0 = (pn - 16) * 256; }
        else if (pn < 30) { base = GA; ldc = 2048; c0 = (pn - 22) * 256; bias = b_gate + c0; }
        else { base = GB; ldc = 2048; c0 = (pn - 30) * 256; bias = b_gate + 2048 + c0; }
        if (base == nullptr) {
            if (wc < 2) {
#pragma unroll
                for (int ai = 0; ai < 2; ++ai)
#pragma unroll
                    for (int m = 0; m < 4; ++m) { const int row = row0 + ai * HALF + m * 16; const float rs = rstd0[row];
                        float* p = KPER + (size_t)row * 64 + cw; *(f32x4*)p = acc[ai][0][m][0] * rs; *(f32x4*)(p + 4) = acc[ai][0][m][1] * rs; }
            }
            return;
        }
        f32x4 bv[2][2];
#pragma unroll
        for (int bj = 0; bj < 2; ++bj)
#pragma unroll
            for (int n = 0; n < 2; ++n) bv[bj][n] = bias ? *(const f32x4*)(bias + bj * HALF + cw + 4 * n) : (f32x4){0.f, 0.f, 0.f, 0.f};
#pragma unroll
        for (int ai = 0; ai < 2; ++ai)
#pragma unroll
            for (int m = 0; m < 4; ++m) { const int row = row0 + ai * HALF + m * 16; const float rs = rstd0[row]; bf16_t* rowp = base + (size_t)row * ldc + c0 + cw; float s = 0.f;
#pragma unroll
                for (int bj = 0; bj < 2; ++bj) { f32x4 v0 = acc[ai][bj][m][0] * rs, v1 = acc[ai][bj][m][1] * rs;
                    if (bias) { v0 = v0 + bv[bj][0]; v1 = v1 + bv[bj][1];
#pragma unroll
                        for (int e = 0; e < 4; ++e) { v0[e] = sigm(v0[e]); v1[e] = sigm(v1[e]); } }
                    s += sq8(v0, v1);
                    *(u32x4*)(rowp + bj * HALF) = pack8(v0, v1); }
                if (ssq) { s += __shfl_xor(s, 16); s += __shfl_xor(s, 32); if (fq == 0) atomicAdd(ssq + row, s); } }
    }
};

struct EpiRowScale {
    static constexpr bool PERM = true, AFTER_DRAIN = false;
    bf16_t *O0, *O1; int split, ldc; const float* ssq; float inv_dim;
    __device__ __forceinline__ void operator()(const f32x4 (&acc)[2][2][4][2], const Unit& u, int wr, int wc, int fr, int fq) const {
        const int pn = u.pn; const int row0 = u.pm * BM + wr * 64 + fr; const int cw = wc * 32 + 8 * fq;
        bf16_t* base = pn < split ? O0 : O1; const int c0 = (pn < split ? pn : pn - split) * 256;
#pragma unroll
        for (int ai = 0; ai < 2; ++ai)
#pragma unroll
            for (int m = 0; m < 4; ++m) { const int row = row0 + ai * HALF + m * 16; const float rs = rsqrtf(ssq[row] * inv_dim + NORM_EPS_F); bf16_t* rowp = base + (size_t)row * ldc + c0 + cw;
#pragma unroll
                for (int bj = 0; bj < 2; ++bj) *(u32x4*)(rowp + bj * HALF) = pack8(acc[ai][bj][m][0] * rs, acc[ai][bj][m][1] * rs); }
    }
};

struct EpiGate {
    static constexpr bool PERM = true, AFTER_DRAIN = false;
    const bf16_t* G; const float* addin; float* outf; bf16_t* outb;
    __device__ __forceinline__ void operator()(const f32x4 (&acc)[2][2][4][2], const Unit& u, int wr, int wc, int fr, int fq) const {
        const int row0 = u.pm * BM + wr * 64 + fr; const int col0 = u.pn * BM + wc * 32 + 8 * fq;
#pragma unroll
        for (int ai = 0; ai < 2; ++ai)
#pragma unroll
            for (int m = 0; m < 4; ++m) { const size_t off = (size_t)(row0 + ai * HALF + m * 16) * 2048 + col0;
#pragma unroll
                for (int bj = 0; bj < 2; ++bj) { const u32x4 g = *(const u32x4*)(G + off + bj * HALF);
                    f32x4 v0 = acc[ai][bj][m][0] * (f32x4){bf_lo(g.x), bf_hi(g.x), bf_lo(g.y), bf_hi(g.y)};
                    f32x4 v1 = acc[ai][bj][m][1] * (f32x4){bf_lo(g.z), bf_hi(g.z), bf_lo(g.w), bf_hi(g.w)};
                    if (addin) { v0 = v0 + *(const f32x4*)(addin + off + bj * HALF); v1 = v1 + *(const f32x4*)(addin + off + bj * HALF + 4); }
                    if (outf) { *(f32x4*)(outf + off + bj * HALF) = v0; *(f32x4*)(outf + off + bj * HALF + 4) = v1; }
                    if (outb) *(u32x4*)(outb + off + bj * HALF) = pack8(v0, v1); } }
    }
};

struct EpiResid {
    static constexpr bool PERM = true, AFTER_DRAIN = false;
    const float* resid; float* outf; bf16_t* outb; float* ssq;
    __device__ __forceinline__ void operator()(const f32x4 (&acc)[2][2][4][2], const Unit& u, int wr, int wc, int fr, int fq) const {
        const int row0 = u.pm * BM + wr * 64 + fr; const int col0 = u.pn * BM + wc * 32 + 8 * fq;
#pragma unroll
        for (int ai = 0; ai < 2; ++ai)
#pragma unroll
            for (int m = 0; m < 4; ++m) { const int row = row0 + ai * HALF + m * 16; const size_t off = (size_t)row * 2048 + col0; float s = 0.f;
#pragma unroll
                for (int bj = 0; bj < 2; ++bj) { const f32x4 v0 = acc[ai][bj][m][0] + *(const f32x4*)(resid + off + bj * HALF), v1 = acc[ai][bj][m][1] + *(const f32x4*)(resid + off + bj * HALF + 4);
                    s += sq8(v0, v1);
                    *(f32x4*)(outf + off + bj * HALF) = v0; *(f32x4*)(outf + off + bj * HALF + 4) = v1;
                    if (outb) *(u32x4*)(outb + off + bj * HALF) = pack8(v0, v1); }
                s += __shfl_xor(s, 16); s += __shfl_xor(s, 32); if (fq == 0) atomicAdd(ssq + row, s); }
    }
};

template <class Epi, class Sched, bool ALIGN_EPI = false, bool SP2 = false>
__device__ __forceinline__ void gemm_phase(PG8_LAS unsigned char* lds, const Gemm g, const Sched& S, const Epi& E) {
    const int tid = threadIdx.x, wid = __builtin_amdgcn_readfirstlane(tid >> 6), lane = tid & 63, wr = wid >> 2, wc = wid & 3, fr = lane & 15, fq = lane >> 4;
    const int K = g.K, nt = K / BK;
    unsigned voffA[2], voffB[2];
#pragma unroll
    for (int i = 0; i < 2; ++i) { int R, C; stage_rc(tid * 16 + i * 8192, R, C); const int Rb = Epi::PERM ? ((R & ~31) + perm32(R & 31)) : R;
        voffA[i] = (unsigned)(R * K + C) * 2u; voffB[i] = (unsigned)(Rb * K + C) * 2u; }
    const size_t kstep = (size_t)(BK * 2);
    const size_t hstep = (size_t)HALF * K * 2;
    const size_t tstep = 2 * hstep;
    const unsigned ldsw = (unsigned)wid * 1024u;
    const int aoff = lds_byte(wr * 64 + fr, fq * 8), boff = lds_byte(wc * 32 + fr, fq * 8);
#define PG8_SA(b, h) (((b) * 2 + (h)) * HTB)
#define PG8_SB(b, h) ((4 + (b) * 2 + (h)) * HTB)
#define PG8_STAGE(bufoff, gbase, voff) do { _Pragma("unroll") for (int _i = 0; _i < 2; ++_i) \
        __builtin_amdgcn_global_load_lds((const unsigned*)((const char*)(gbase) + (voff)[_i]), (PG8_LAS unsigned*)(lds + (bufoff) + ldsw + _i * 8192), 16, 0, 0); } while (0)
#define PG8_LDA(dst, b, h) do { _Pragma("unroll") for (int m = 0; m < 4; ++m) _Pragma("unroll") for (int k = 0; k < 2; ++k) dst[m][k] = *(const PG8_LAS bf16x8*)(lds + PG8_SA(b, h) + aoff + m * 2048 + k * 1024); } while (0)
#define PG8_LDB(dst, b, h) do { _Pragma("unroll") for (int n = 0; n < 2; ++n) _Pragma("unroll") for (int k = 0; k < 2; ++k) dst[n][k] = *(const PG8_LAS bf16x8*)(lds + PG8_SB(b, h) + boff + n * 2048 + k * 1024); } while (0)
#define PG8_MMA(ai, bj, At, Bt) do { __builtin_amdgcn_s_setprio(1); _Pragma("unroll") for (int m = 0; m < 4; ++m) _Pragma("unroll") for (int n = 0; n < 2; ++n) _Pragma("unroll") for (int k = 0; k < 2; ++k) \
        acc[ai][bj][m][n] = __builtin_amdgcn_mfma_f32_16x16x32_bf16(Bt[n][k], At[m][k], acc[ai][bj][m][n], 0, 0, 0); __builtin_amdgcn_s_setprio(0); } while (0)
#define PG8_WAIT_V(n) asm volatile("s_waitcnt vmcnt(" #n ")" ::: "memory")
#define PG8_WAIT_L(n) asm volatile("s_waitcnt lgkmcnt(" #n ")" ::: "memory")
#define PG8_BAR __builtin_amdgcn_s_barrier()
#define PG8_SCHED __builtin_amdgcn_sched_barrier(0)
    Unit cur, nxt; int ui = 0;
    if (!S.next(0, cur)) return;
    f32x4 acc[2][2][4][2];
#pragma unroll
    for (int a = 0; a < 2; ++a)
#pragma unroll
        for (int b = 0; b < 2; ++b)
#pragma unroll
            for (int m = 0; m < 4; ++m)
#pragma unroll
                for (int n = 0; n < 2; ++n) acc[a][b][m][n] = (f32x4){0.f, 0.f, 0.f, 0.f};
    bf16x8 At[4][2], B0[2][2], B1[2][2];
    const char* cA = (const char*)g.A + (size_t)cur.pm * tstep; const char* cB = (const char*)g.Bt + (size_t)cur.pn * tstep;
    S.a_ready(cur);
    if constexpr (SP2) {
        PG8_STAGE(PG8_SB(0, 0), cB, voffB); PG8_STAGE(PG8_SB(0, 1), cB + hstep, voffB); PG8_STAGE(PG8_SA(0, 0), cA, voffA); PG8_STAGE(PG8_SA(0, 1), cA + hstep, voffA);
        if (wr == 1) PG8_BAR;
        PG8_WAIT_V(2); PG8_BAR;
        PG8_STAGE(PG8_SB(1, 0), cB + kstep, voffB); PG8_STAGE(PG8_SA(1, 0), cA + kstep, voffA); PG8_STAGE(PG8_SB(1, 1), cB + hstep + kstep, voffB);
        PG8_WAIT_V(6); PG8_BAR;
    } else {
        PG8_STAGE(PG8_SB(0, 0), cB, voffB); PG8_STAGE(PG8_SA(0, 0), cA, voffA); PG8_STAGE(PG8_SB(0, 1), cB + hstep, voffB); PG8_STAGE(PG8_SA(0, 1), cA + hstep, voffA);
        if (wr == 1) PG8_BAR;
        PG8_WAIT_V(4); PG8_BAR;
        PG8_STAGE(PG8_SB(1, 0), cB + kstep, voffB); PG8_STAGE(PG8_SA(1, 0), cA + kstep, voffA); PG8_STAGE(PG8_SB(1, 1), cB + hstep + kstep, voffB);
        PG8_WAIT_V(6); PG8_BAR;
    }
    for (;;) {
        const bool has_next = S.next(ui + 1, nxt);
        const char* nA = has_next ? (const char*)g.A + (size_t)nxt.pm * tstep : cA; const char* nB = has_next ? (const char*)g.Bt + (size_t)nxt.pn * tstep : cB;
        for (int t = 0; t < nt; t += 2) {
            const bool last = (t == nt - 2);
            const char* a1 = cA + (size_t)(t + 1) * kstep;
            const char* a2 = last ? nA : cA + (size_t)(t + 2) * kstep; const char* b2 = last ? nB : cB + (size_t)(t + 2) * kstep;
            const char* a3 = a2 + kstep; const char* b3 = b2 + kstep;
            if (last && has_next) S.a_ready(nxt);
            if constexpr (SP2) {
            PG8_LDB(B0, 0, 0); PG8_LDB(B1, 0, 1); PG8_SCHED; PG8_LDA(At, 0, 0); PG8_STAGE(PG8_SA(1, 1), a1 + hstep, voffA);
            PG8_WAIT_V(8); PG8_WAIT_L(0); PG8_BAR; PG8_MMA(0, 0, At, B0); PG8_MMA(0, 1, At, B1); PG8_BAR; PG8_SCHED;
            PG8_LDA(At, 0, 1); PG8_STAGE(PG8_SB(0, 0), b2, voffB); PG8_STAGE(PG8_SB(0, 1), b2 + hstep, voffB); PG8_STAGE(PG8_SA(0, 0), a2, voffA);
            PG8_WAIT_V(8); PG8_WAIT_L(0); PG8_BAR; PG8_MMA(1, 0, At, B0); PG8_MMA(1, 1, At, B1); PG8_BAR; PG8_SCHED;
            PG8_LDB(B0, 1, 0); PG8_LDB(B1, 1, 1); PG8_SCHED; PG8_LDA(At, 1, 0); PG8_STAGE(PG8_SA(0, 1), a2 + hstep, voffA);
            PG8_WAIT_V(8); PG8_WAIT_L(0); PG8_BAR; PG8_MMA(0, 0, At, B0); PG8_MMA(0, 1, At, B1); PG8_BAR; PG8_SCHED;
            PG8_LDA(At, 1, 1); PG8_STAGE(PG8_SB(1, 0), b3, voffB); PG8_STAGE(PG8_SB(1, 1), b3 + hstep, voffB); PG8_STAGE(PG8_SA(1, 0), a3, voffA);
            PG8_WAIT_V(8); PG8_WAIT_L(0); PG8_BAR; PG8_MMA(1, 0, At, B0); PG8_MMA(1, 1, At, B1); PG8_BAR; PG8_SCHED;
            } else {
            PG8_LDB(B0, 0, 0); PG8_SCHED; PG8_LDA(At, 0, 0); PG8_STAGE(PG8_SA(1, 1), a1 + hstep, voffA);
            PG8_WAIT_L(8); PG8_BAR; PG8_WAIT_L(0); PG8_MMA(0, 0, At, B0); PG8_BAR; PG8_SCHED;
            PG8_LDB(B1, 0, 1); PG8_STAGE(PG8_SB(0, 0), b2, voffB);
            PG8_BAR; PG8_WAIT_L(0); PG8_MMA(0, 1, At, B1); PG8_BAR;
            PG8_LDA(At, 0, 1); PG8_STAGE(PG8_SA(0, 0), a2, voffA);
            PG8_BAR; PG8_WAIT_L(0); PG8_MMA(1, 0, At, B0); PG8_BAR; PG8_SCHED;
            PG8_STAGE(PG8_SB(0, 1), b2 + hstep, voffB);
            PG8_WAIT_V(6); PG8_BAR; PG8_MMA(1, 1, At, B1); PG8_BAR;
            PG8_LDB(B0, 1, 0); PG8_SCHED; PG8_LDA(At, 1, 0); PG8_STAGE(PG8_SA(0, 1), a2 + hstep, voffA);
            PG8_WAIT_L(8); PG8_BAR; PG8_WAIT_L(0); PG8_MMA(0, 0, At, B0); PG8_BAR; PG8_SCHED;
            PG8_LDB(B1, 1, 1); PG8_STAGE(PG8_SB(1, 0), b3, voffB);
            PG8_BAR; PG8_WAIT_L(0); PG8_MMA(0, 1, At, B1); PG8_BAR;
            PG8_LDA(At, 1, 1); PG8_STAGE(PG8_SA(1, 0), a3, voffA);
            PG8_BAR; PG8_WAIT_L(0); PG8_MMA(1, 0, At, B0); PG8_BAR; PG8_SCHED;
            PG8_STAGE(PG8_SB(1, 1), b3 + hstep, voffB);
            PG8_WAIT_V(6); PG8_BAR; PG8_MMA(1, 1, At, B1); PG8_BAR;
            }
        }
        if constexpr (ALIGN_EPI) { if (wr == 0) PG8_BAR; }
        if constexpr (!Epi::AFTER_DRAIN) { E(acc, cur, wr, wc, fr, fq); S.done(cur); }
        if (!has_next) break;
#pragma unroll
        for (int a = 0; a < 2; ++a)
#pragma unroll
            for (int b = 0; b < 2; ++b)
#pragma unroll
                for (int m = 0; m < 4; ++m)
#pragma unroll
                    for (int n = 0; n < 2; ++n) acc[a][b][m][n] = (f32x4){0.f, 0.f, 0.f, 0.f};
        cur = nxt; cA = nA; cB = nB; ++ui;
        if constexpr (ALIGN_EPI) { if (wr == 1) PG8_BAR; }
    }
    PG8_WAIT_V(0);
    if constexpr (!ALIGN_EPI) { if (wr == 0) PG8_BAR; }
    PG8_BAR;
    if constexpr (Epi::AFTER_DRAIN) { E.fused(acc, cur, wr, wc, fr, fq, lds, wid, lane); S.done(cur); }
#undef PG8_SA
#undef PG8_SB
#undef PG8_STAGE
#undef PG8_LDA
#undef PG8_LDB
#undef PG8_MMA
#undef PG8_WAIT_V
#undef PG8_WAIT_L
#undef PG8_BAR
#undef PG8_SCHED
}
}
#define LAS __attribute__((address_space(3)))
typedef unsigned short bf16;
typedef float f32x4 __attribute__((ext_vector_type(4)));
typedef float f32x2v __attribute__((ext_vector_type(2)));
typedef float f32x16 __attribute__((ext_vector_type(16)));
typedef unsigned v4u __attribute__((ext_vector_type(4)));
typedef unsigned v2u __attribute__((ext_vector_type(2)));
typedef short bf16x8 __attribute__((ext_vector_type(8)));
using pg8::cvt_pk_bf16;
__device__ __forceinline__ float bflo(unsigned w) { return __uint_as_float(w << 16); }
__device__ __forceinline__ float bfhi(unsigned w) { return __uint_as_float(w & 0xffff0000u); }
__device__ __forceinline__ float wave_sum(float v) {
#pragma unroll
    for (int o = 1; o < 64; o <<= 1) v += __shfl_xor(v, o);
    return v;
}

constexpr int VT_STR = 144;
template <int DQK, bool ROPEQ>
__device__ __forceinline__ void attn_unit(LAS unsigned char* lds,
        const bf16* Qb, long q_pitch, const bf16* Kb, long k_pitch, const bf16* Kpe, long kpe_pitch, const bf16* Vb, long v_pitch,
        bf16* Ob, long o_pitch, float* lse, long lse_pitch, int q0, int W, float sc2, float slope2, const f32x2v* rope) {
    constexpr int KSTR = DQK * 2 + 16;
    constexpr int ND0 = DQK / 16;
    LAS unsigned char* Kt = lds;
    LAS unsigned char* Vt = lds + 64 * KSTR;
    const int tid = threadIdx.x, lane = tid & 63, r32 = lane & 31, hi = lane >> 5; const int wid = __builtin_amdgcn_readfirstlane(tid >> 6);
    const int qlo = q0 + 32 * wid, qrow = qlo + r32;
    bf16x8 qf[ND0];
    { const bf16* qp = Qb + (long)qrow * q_pitch + 8 * hi;
#pragma unroll
      for (int d0 = 0; d0 < ND0; ++d0) qf[d0] = *(const bf16x8*)(qp + 16 * d0); }
    if constexpr (ROPEQ) {
#pragma unroll
        for (int dp = 0; dp < 2; ++dp) {
            const f32x2v* rp = rope + (long)qrow * 32 + 16 * dp + 8 * hi;
            bf16x8 x1 = qf[8 + dp], x2 = qf[10 + dp]; bf16x8 y1, y2;
#pragma unroll
            for (int j = 0; j < 8; j += 2) {
                const f32x2v cs0 = rp[j], cs1 = rp[j + 1];
                const float a0 = __uint_as_float(((unsigned)(unsigned short)x1[j]) << 16), a1 = __uint_as_float(((unsigned)(unsigned short)x1[j + 1]) << 16);
                const float b0 = __uint_as_float(((unsigned)(unsigned short)x2[j]) << 16), b1 = __uint_as_float(((unsigned)(unsigned short)x2[j + 1]) << 16);
                const unsigned w1 = cvt_pk_bf16(a0 * cs0.x - b0 * cs0.y, a1 * cs1.x - b1 * cs1.y);
                const unsigned w2 = cvt_pk_bf16(b0 * cs0.x + a0 * cs0.y, b1 * cs1.x + a1 * cs1.y);
                y1[j] = (short)(w1 & 0xffffu); y1[j + 1] = (short)(w1 >> 16); y2[j] = (short)(w2 & 0xffffu); y2[j + 1] = (short)(w2 >> 16);
            }
            qf[8 + dp] = y1; qf[10 + dp] = y2;
        }
    }
    f32x16 o[4];
#pragma unroll
    for (int i = 0; i < 4; ++i) o[i] = f32x16{};
    float m_run = -1e30f, l_run = 0.f;
    const int kt_hi = (q0 >> 6) + 3; int kt_lo = (q0 - W) >> 6; if (kt_lo < 0) kt_lo = 0;
    const int kr0 = tid >> 4, kc0 = tid & 15;
    const int pr = tid >> 3, pc = tid & 7;
    const int vc0 = wid, vc1 = wid + 8;
    v4u kreg0, kreg1, preg = (v4u){0u, 0u, 0u, 0u}, vreg0, vreg1;
    const unsigned koff0 = (unsigned)((kr0 * k_pitch + 8 * kc0) * 2), koff1 = (unsigned)(((kr0 + 32) * k_pitch + 8 * kc0) * 2), poff = (unsigned)((pr * kpe_pitch + 8 * pc) * 2);
    const unsigned voff0 = (unsigned)((lane * v_pitch + 8 * vc0) * 2), voff1 = voff0 + 128u;
#define ATT_LOAD(kt) do { const char* kb_ = (const char*)Kb + (size_t)(kt) * 128 * (size_t)k_pitch; const char* vb_ = (const char*)Vb + (size_t)(kt) * 128 * (size_t)v_pitch; \
        kreg0 = *(const v4u*)(kb_ + koff0); kreg1 = *(const v4u*)(kb_ + koff1); \
        if constexpr (DQK == 192) { const char* pb_ = (const char*)Kpe + (size_t)(kt) * 128 * (size_t)kpe_pitch; preg = *(const v4u*)(pb_ + poff); } \
        vreg0 = *(const v4u*)(vb_ + voff0); vreg1 = *(const v4u*)(vb_ + voff1); } while (0)
    ATT_LOAD(kt_lo);
    const int pir = (r32 & ~12) | ((r32 & 4) << 1) | ((r32 & 8) >> 1);
    const LAS unsigned char* kread = Kt + pir * KSTR + hi * 16;
    const LAS unsigned char* vread = Vt + r32 * VT_STR + hi * 16;
    for (int kt = kt_lo; kt <= kt_hi; ++kt) {
        __syncthreads();
        *(LAS v4u*)(Kt + kr0 * KSTR + kc0 * 16) = kreg0; *(LAS v4u*)(Kt + (kr0 + 32) * KSTR + kc0 * 16) = kreg1;
        if constexpr (DQK == 192) *(LAS v4u*)(Kt + pr * KSTR + 256 + pc * 16) = preg;
        {
            LAS unsigned short* v0p = (LAS unsigned short*)(Vt + (8 * vc0) * VT_STR + lane * 2);
            LAS unsigned short* v1p = (LAS unsigned short*)(Vt + (8 * vc1) * VT_STR + lane * 2);
#pragma unroll
            for (int j = 0; j < 4; ++j) {
                v0p[(2 * j) * (VT_STR / 2)] = (unsigned short)(vreg0[j] & 0xffffu); v0p[(2 * j + 1) * (VT_STR / 2)] = (unsigned short)(vreg0[j] >> 16);
                v1p[(2 * j) * (VT_STR / 2)] = (unsigned short)(vreg1[j] & 0xffffu); v1p[(2 * j + 1) * (VT_STR / 2)] = (unsigned short)(vreg1[j] >> 16);
            }
        }
        if (kt < kt_hi) ATT_LOAD(kt + 1);
        __syncthreads();
        const int k0 = kt * 64;
        if (k0 > qlo + 31 || k0 + 63 < qlo - W) continue;
        f32x16 p0 = f32x16{}, p1 = f32x16{};
#pragma unroll
        for (int d0 = 0; d0 < ND0; ++d0) {
            const bf16x8 a0 = *(const LAS bf16x8*)(kread + d0 * 32), a1 = *(const LAS bf16x8*)(kread + 32 * KSTR + d0 * 32);
            p0 = __builtin_amdgcn_mfma_f32_32x32x16_bf16(a0, qf[d0], p0, 0, 0, 0);
            p1 = __builtin_amdgcn_mfma_f32_32x32x16_bf16(a1, qf[d0], p1, 0, 0, 0);
        }
        const bool need_mask = (k0 + 63 > qlo) || (k0 < qlo + 31 - W);
        const int dbase = qrow - k0 - 8 * hi;
        float mx = -INFINITY;
#pragma unroll
        for (int r = 0; r < 16; ++r) {
            const int d0_ = dbase - 16 * (r >> 3) - (r & 7), d1_ = d0_ - 32;
            float s0 = p0[r] * sc2 - slope2 * (float)d0_, s1 = p1[r] * sc2 - slope2 * (float)d1_;
            if (need_mask) { if (d0_ < 0 || d0_ > W) s0 = -INFINITY; if (d1_ < 0 || d1_ > W) s1 = -INFINITY; }
            p0[r] = s0; p1[r] = s1; mx = fmaxf(mx, fmaxf(s0, s1));
        }
        mx = fmaxf(mx, __shfl_xor(mx, 32));
        const float m_new = fmaxf(m_run, mx), alpha = __builtin_amdgcn_exp2f(m_run - m_new);
        m_run = m_new;
        float rs = 0.f;
#pragma unroll
        for (int r = 0; r < 16; ++r) { p0[r] = __builtin_amdgcn_exp2f(p0[r] - m_new); p1[r] = __builtin_amdgcn_exp2f(p1[r] - m_new); rs += p0[r] + p1[r]; }
        l_run = l_run * alpha + rs;
#pragma unroll
        for (int i = 0; i < 4; ++i)
#pragma unroll
            for (int r = 0; r < 16; ++r) o[i][r] *= alpha;
        bf16x8 pf[4];
#pragma unroll
        for (int s = 0; s < 2; ++s) {
            v4u w0, w1;
            w0.x = cvt_pk_bf16(p0[8 * s + 0], p0[8 * s + 1]); w0.y = cvt_pk_bf16(p0[8 * s + 2], p0[8 * s + 3]); w0.z = cvt_pk_bf16(p0[8 * s + 4], p0[8 * s + 5]); w0.w = cvt_pk_bf16(p0[8 * s + 6], p0[8 * s + 7]);
            w1.x = cvt_pk_bf16(p1[8 * s + 0], p1[8 * s + 1]); w1.y = cvt_pk_bf16(p1[8 * s + 2], p1[8 * s + 3]); w1.z = cvt_pk_bf16(p1[8 * s + 4], p1[8 * s + 5]); w1.w = cvt_pk_bf16(p1[8 * s + 6], p1[8 * s + 7]);
            pf[s] = __builtin_bit_cast(bf16x8, w0); pf[2 + s] = __builtin_bit_cast(bf16x8, w1);
        }
#pragma unroll
        for (int db = 0; db < 4; ++db)
#pragma unroll
            for (int s = 0; s < 4; ++s) {
                const bf16x8 vf = *(const LAS bf16x8*)(vread + db * 32 * VT_STR + s * 32);
                o[db] = __builtin_amdgcn_mfma_f32_32x32x16_bf16(vf, pf[s], o[db], 0, 0, 0);
            }
    }
#undef ATT_LOAD
    const float l_tot = l_run + __shfl_xor(l_run, 32), inv = 1.0f / l_tot;
    bf16* op = Ob + (long)qrow * o_pitch + 4 * hi;
#pragma unroll
    for (int db = 0; db < 4; ++db)
#pragma unroll
        for (int g = 0; g < 4; ++g) { v2u w; w.x = cvt_pk_bf16(o[db][4 * g] * inv, o[db][4 * g + 1] * inv); w.y = cvt_pk_bf16(o[db][4 * g + 2] * inv, o[db][4 * g + 3] * inv);
            *(v2u*)(op + 32 * db + 8 * g) = w; }
    if (lse != nullptr && hi == 0) lse[(long)qrow * lse_pitch] = (m_run + __builtin_amdgcn_logf(l_tot)) * 0.6931471805599453f;
}
constexpr int T = 16384, SEQ = 4096, DM = 2048, DFF = 5504, NUP = 2 * DFF;
constexpr int N_IN_PAD = 9728;
constexpr int UP_TILES_A = 24, UP_TILES_B = 19;
constexpr size_t MiB = 1u << 20;
constexpr size_t WS_RSTD0 = 0, WS_SSQQ = 65536, WS_SSQKV = 2 * 65536, WS_SSQ1 = 3 * 65536, WS_SSQ2 = 4 * 65536;
constexpr size_t WS_LSE = 1 * MiB;
constexpr size_t WS_ROPE = 2 * MiB;
constexpr size_t WS_WUQ = 3 * MiB;
constexpr size_t WS_WKV = WS_WUQ + 1536 * 512 * 2;
constexpr size_t WS_WOM = WS_WKV + 2048 * 256 * 2;
constexpr size_t WS_WOD = WS_WOM + 2048 * 1024 * 2;
constexpr size_t WS_WOUT = WS_WOD + 2048 * 512 * 2;
constexpr size_t WS_A = 19 * MiB + 512 * 1024;
constexpr size_t WS_C = 83 * MiB + 512 * 1024;
constexpr size_t WS_WIN = WS_C, WS_V = WS_C;
constexpr size_t WS_CQ = 122 * MiB, WS_CKV = 138 * MiB, WS_KPER = 146 * MiB;
constexpr size_t WS_WDN = WS_C, WS_WUP = WS_WDN + (size_t)DM * DFF * 2;
constexpr size_t WS_E = 150 * MiB;
constexpr size_t WS_DQ = WS_E, WS_DK = WS_E + 48 * MiB, WS_DV = WS_E + 96 * MiB;
constexpr size_t WS_ATT = WS_E, WS_DIL = WS_E + 32 * MiB;
constexpr size_t WS_GA = 294 * MiB, WS_GB = 358 * MiB;
constexpr size_t WS_G = 422 * MiB;
constexpr size_t WS_Q = WS_G, WS_KN = WS_G + 48 * MiB, WS_KPE = WS_G + 80 * MiB, WS_MERGEB = WS_G;
constexpr size_t WS_U = 148 * MiB;
constexpr size_t WS_ACT = 340 * MiB;
constexpr size_t WS_END = 512 * MiB;
static_assert(WS_WOUT + (size_t)DM * DM * 2 <= WS_A && WS_A + 64 * MiB <= WS_C && WS_C + 38 * MiB <= WS_CQ, "small weights / A / C");
static_assert(WS_WUP + (size_t)NUP * DM * 2 <= WS_U, "wup");
static_assert((size_t)T * UP_TILES_A * 256 * 2 == 192 * MiB, "U");
constexpr size_t WS_ACT_REAL = WS_U + 192 * MiB;
static_assert(WS_ACT_REAL + (size_t)T * DFF * 2 <= WS_END, "ACT must fit");

struct Args { const float* in[17]; float* out; unsigned char* ws; int ph_lo, ph_hi, coop, pad; };

__device__ __forceinline__ int map_row(int code, int n) {
    switch (code) {
        case 1: return n < 832 ? n : n + 192;
        case 2: { const int h = n >> 8, j = n & 255; return j < 128 ? h * 128 + j : 1024 + h * 128 + (j - 128); }
        case 3: { const int gate = n >= DFF ? 1 : 0, c = n - gate * DFF; return (c >> 7) * 256 + gate * 128 + (c & 127); }
        default: return n;
    }
}
__device__ __forceinline__ void conv_item(const float* W, int K, int N, bf16* WT, const float* g, int code, LAS float* scr, int item, int lane) {
    const int nblk = N / 32, kb = item / nblk, nb = item % nblk, k0 = 64 * kb, n0 = 32 * nb;
    const int drow0 = map_row(code, n0);
#pragma unroll 8
    for (int i = 0; i < 32; ++i) { const int kk = 2 * i + (lane >> 5); float v = W[(size_t)(k0 + kk) * N + n0 + (lane & 31)]; if (g) v *= g[k0 + kk]; scr[kk * 33 + (lane & 31)] = v; }
    asm volatile("s_waitcnt lgkmcnt(0)" ::: "memory");
    const int c = lane & 7;
#pragma unroll
    for (int j = 0; j < 4; ++j) { const int n = (lane >> 3) + 8 * j; const LAS float* s = scr + (8 * c) * 33 + n;
        v4u o; o.x = cvt_pk_bf16(s[0 * 33], s[1 * 33]); o.y = cvt_pk_bf16(s[2 * 33], s[3 * 33]); o.z = cvt_pk_bf16(s[4 * 33], s[5 * 33]); o.w = cvt_pk_bf16(s[6 * 33], s[7 * 33]);
        *(v4u*)(WT + (size_t)(drow0 + n) * K + k0 + 8 * c) = o; }
    asm volatile("s_waitcnt lgkmcnt(0)" ::: "memory");
}
__device__ __forceinline__ void conv_matrix(const float* W, int K, int N, bf16* WT, const float* g, int code, LAS float* scr, int gw, int NGW, int lane) {
    const int nitems = (K / 64) * (N / 32);
    for (int it = gw; it < nitems; it += NGW) conv_item(W, K, N, WT, g, code, scr, it, lane);
}
__device__ __forceinline__ void row_to_bf16_rstd(const float* xrow, bf16* orow, float* rstd_out, int lane) {
    const f32x4* xr = (const f32x4*)xrow + lane; f32x4 v[8]; float s = 0.f;
#pragma unroll
    for (int j = 0; j < 8; ++j) { v[j] = xr[64 * j]; s += (v[j].x * v[j].x + v[j].y * v[j].y) + (v[j].z * v[j].z + v[j].w * v[j].w); }
    s = wave_sum(s);
    if (lane == 0) *rstd_out = rsqrtf(s * (1.0f / DM) + 1e-6f);
    v2u* o8 = (v2u*)orow + lane;
#pragma unroll
    for (int j = 0; j < 8; ++j) { v2u w; w.x = cvt_pk_bf16(v[j].x, v[j].y); w.y = cvt_pk_bf16(v[j].z, v[j].w); o8[64 * j] = w; }
}

constexpr int LDS_BYTES = 147456;
__global__ void __launch_bounds__(512, 2) fwd_mega(Args args) {
    extern __shared__ __attribute__((aligned(16))) unsigned char lds_raw[];
    LAS unsigned char* lds = (LAS unsigned char*)lds_raw;
    cg::grid_group grid = cg::this_grid();
    const int G = gridDim.x, bid = blockIdx.x;
    const int NGW = G * 8, NGT = G * 512;
#define FRESH() int tid = threadIdx.x; asm volatile("" : "+v"(tid)); const int lane = tid & 63; const int wave = __builtin_amdgcn_readfirstlane(tid >> 6); \
    const int gw = bid * 8 + wave; const int gt = bid * 512 + tid; LAS float* scr = (LAS float*)(lds + wave * 16384); (void)lane; (void)gw; (void)gt; (void)scr
    unsigned char* ws = args.ws;
    const float* x = args.in[0]; const float* attn_norm_g = args.in[1]; const float* w_in = args.in[2]; const float* b_gate = args.in[3];
    const float* q_norm_g = args.in[4]; const float* w_uq = args.in[5]; const float* kv_norm_g = args.in[6]; const float* w_ukv = args.in[7];
    const float* w_o_mla = args.in[8]; const float* w_o_dil = args.in[9]; const float* w_out = args.in[10]; const float* ffn_norm_g = args.in[11];
    const float* w_up = args.in[12]; const float* conv_w = args.in[13]; const float* conv_b = args.in[14]; const float* w_down = args.in[15]; const float* final_norm_g = args.in[16];
    float* out = args.out;
    float* RSTD0 = (float*)(ws + WS_RSTD0); float* SSQQ = (float*)(ws + WS_SSQQ); float* SSQKV = (float*)(ws + WS_SSQKV); float* SSQ1 = (float*)(ws + WS_SSQ1); float* SSQ2 = (float*)(ws + WS_SSQ2);
    float* LSE = (float*)(ws + WS_LSE); f32x2v* ROPE = (f32x2v*)(ws + WS_ROPE);
    bf16* WUQ = (bf16*)(ws + WS_WUQ); bf16* WKV = (bf16*)(ws + WS_WKV); bf16* WOM = (bf16*)(ws + WS_WOM); bf16* WOD = (bf16*)(ws + WS_WOD); bf16* WOUT = (bf16*)(ws + WS_WOUT);
    bf16* WIN = (bf16*)(ws + WS_WIN); bf16* WDN = (bf16*)(ws + WS_WDN); bf16* WUP = (bf16*)(ws + WS_WUP);
    bf16* XB = (bf16*)(ws + WS_A); bf16* OG = (bf16*)(ws + WS_A); bf16* X1B = (bf16*)(ws + WS_A);
    bf16* CQ = (bf16*)(ws + WS_CQ); bf16* CKV = (bf16*)(ws + WS_CKV); float* KPER = (float*)(ws + WS_KPER);
    bf16* DQ = (bf16*)(ws + WS_DQ); bf16* DK = (bf16*)(ws + WS_DK); bf16* DV = (bf16*)(ws + WS_DV);
    bf16* ATT = (bf16*)(ws + WS_ATT); bf16* DIL = (bf16*)(ws + WS_DIL);
    bf16* GA = (bf16*)(ws + WS_GA); bf16* GB = (bf16*)(ws + WS_GB);
    bf16* Q = (bf16*)(ws + WS_Q); bf16* KN = (bf16*)(ws + WS_KN); bf16* KPE = (bf16*)(ws + WS_KPE); bf16* V = (bf16*)(ws + WS_V); bf16* MERGEB = (bf16*)(ws + WS_MERGEB);
    bf16* U = (bf16*)(ws + WS_U); bf16* ACT = (bf16*)(ws + WS_ACT_REAL);
    float* MERGE = out;
    float* X1 = out;

    const int lo = args.ph_lo, hi = args.ph_hi;
#define IN(k) (lo <= (k) && (k) < hi)
#define SEAM(k) do { if (IN(k) && IN((k) + 1)) { if (args.coop) grid.sync(); } } while (0)

    if (IN(0)) { FRESH();
        conv_matrix(w_in, DM, 9536, WIN, attn_norm_g, 1, scr, gw, NGW, lane);
        conv_matrix(w_uq, 512, 1536, WUQ, q_norm_g, 0, scr, gw, NGW, lane);
        conv_matrix(w_ukv, 256, 2048, WKV, kv_norm_g, 2, scr, gw, NGW, lane);
        conv_matrix(w_o_mla, 1024, 2048, WOM, nullptr, 0, scr, gw, NGW, lane);
        conv_matrix(w_o_dil, 512, 2048, WOD, nullptr, 0, scr, gw, NGW, lane);
        conv_matrix(w_out, 2048, 2048, WOUT, nullptr, 0, scr, gw, NGW, lane);
        for (int m = gw; m < T; m += NGW) row_to_bf16_rstd(x + (size_t)m * DM, XB + (size_t)m * DM, RSTD0 + m, lane);
        for (int i = gt; i < 4 * T; i += NGT) SSQQ[i] = 0.f;
        for (int i = gt; i < SEQ * 32; i += NGT) { const int pos = i >> 5, f = i & 31; const float inv_freq = powf(10000.0f, -(float)(2 * f) / 64.0f); const float ang = (float)pos * inv_freq;
            float sn, cs; sincosf(ang, &sn, &cs); ROPE[i] = (f32x2v){cs, sn}; }
    }
    SEAM(0);
    if (IN(1)) {
        pg8::Gemm g{XB, WIN, T, N_IN_PAD, DM}; pg8::StaticOrder S; S.init(T, N_IN_PAD, G, bid);
        pg8::EpiProj E{CQ, CKV, DQ, DK, DV, GA, GB, KPER, RSTD0, SSQQ, SSQKV, b_gate};
        pg8::gemm_phase<pg8::EpiProj, pg8::StaticOrder, true, true>(lds, g, S, E);
    }
    SEAM(1);
    if (IN(2)) {
        { pg8::Gemm g{CQ, WUQ, T, 1536, 512}; pg8::StaticOrder S; S.init(T, 1536, G, bid);
          pg8::EpiRowScale E{Q, Q, 1000, 1536, SSQQ, 1.0f / 512.0f};
          pg8::gemm_phase<pg8::EpiRowScale, pg8::StaticOrder, true, true>(lds, g, S, E); }
        { pg8::Gemm g{CKV, WKV, T, 2048, 256}; pg8::StaticOrder S; S.init(T, 2048, G, (bid + 128) % G);
          pg8::EpiRowScale E{KN, V, 4, 1024, SSQKV, 1.0f / 256.0f};
          pg8::gemm_phase<pg8::EpiRowScale, pg8::StaticOrder, true, true>(lds, g, S, E); }
        FRESH();
        for (int i = gt; i < T * 32; i += NGT) { const int t = i >> 5, f = i & 31; const float x1 = KPER[(size_t)t * 64 + f], x2 = KPER[(size_t)t * 64 + 32 + f]; const f32x2v cs = ROPE[(t & (SEQ - 1)) * 32 + f];
            KPE[(size_t)t * 64 + f] = (bf16)(cvt_pk_bf16(x1 * cs.x - x2 * cs.y, 0.f) & 0xffffu); KPE[(size_t)t * 64 + 32 + f] = (bf16)(cvt_pk_bf16(x2 * cs.x + x1 * cs.y, 0.f) & 0xffffu); }
        for (int uid = bid; uid < 768; uid += G) {
            const int g = uid >> 8, rem = uid & 255, b = rem >> 6, hs = (rem >> 4) & 3, sub = rem & 15;
            const int dil = g == 0 ? 1 : (g == 1 ? 4 : 16), nblk = 16 / dil, r = sub / nblk, ublk = sub % nblk;
            const float slope = exp2f(-8.0f * (float)(g * 4 + hs + 1) / 12.0f);
            const size_t rowb = (size_t)b * SEQ + r; const int colb = g * 512 + hs * 128;
            attn_unit<128, false>(lds, DQ + rowb * 1536 + colb, (long)dil * 1536, DK + rowb * 1536 + colb, (long)dil * 1536, nullptr, 0, DV + rowb * 1536 + colb, (long)dil * 1536,
                OG + (size_t)g * T * 512 + rowb * 512 + hs * 128, (long)dil * 512, LSE + ((size_t)g * T + rowb) * 4 + hs, (long)dil * 4, ublk * 256, 128,
                0.08838834764831845f * 1.4426950408889634f, slope * (float)dil * 1.4426950408889634f, nullptr);
        }
    }
    SEAM(2);
    if (IN(3)) {
        for (int it = bid; it < 256; it += G) {
            const int bh = it >> 3, s = it & 7, b = bh >> 3, h = bh & 7;
            const size_t rowb = (size_t)b * SEQ;
#pragma unroll 1
            for (int k = 0; k < 2; ++k) { const int qb = k == 0 ? 15 - s : s;
                attn_unit<192, true>(lds, Q + rowb * 1536 + h * 192, 1536, KN + rowb * 1024 + h * 128, 1024, KPE + rowb * 64, 64, V + rowb * 1024 + h * 128, 1024,
                    ATT + rowb * 1024 + h * 128, 1024, nullptr, 0, qb * 256, 1 << 24, 0.07216878364870322f * 1.4426950408889634f, 0.f, ROPE); }
        }
        FRESH();
        for (int i = gt; i < T * 64; i += NGT) {
            const int t = i >> 6, hs = (i >> 4) & 3, c = i & 15;
            const float l0 = LSE[(size_t)t * 4 + hs], l1 = LSE[((size_t)T + t) * 4 + hs], l2 = LSE[((size_t)2 * T + t) * 4 + hs];
            const float mx = fmaxf(l0, fmaxf(l1, l2)); float e0 = __expf(l0 - mx), e1 = __expf(l1 - mx), e2 = __expf(l2 - mx); const float inv = 1.0f / (e0 + e1 + e2); e0 *= inv; e1 *= inv; e2 *= inv;
            const size_t off = (size_t)t * 512 + hs * 128 + c * 8;
            const v4u a = *(const v4u*)(OG + off), b2 = *(const v4u*)(OG + (size_t)T * 512 + off), c2 = *(const v4u*)(OG + (size_t)2 * T * 512 + off); v4u o;
#pragma unroll
            for (int j = 0; j < 4; ++j) o[j] = cvt_pk_bf16(e0 * bflo(a[j]) + e1 * bflo(b2[j]) + e2 * bflo(c2[j]), e0 * bfhi(a[j]) + e1 * bfhi(b2[j]) + e2 * bfhi(c2[j]));
            *(v4u*)(DIL + off) = o;
        }
    }
    SEAM(3);
    if (IN(4)) {
        { FRESH();
        conv_matrix(w_up, DM, NUP, WUP, ffn_norm_g, 3, scr, gw, NGW, lane);
        conv_matrix(w_down, DFF, DM, WDN, nullptr, 0, scr, gw, NGW, lane); }
        __syncthreads();
        { pg8::Gemm g{ATT, WOM, T, DM, 1024}; pg8::StaticOrder S; S.init(T, DM, G, bid);
          pg8::EpiGate E{GA, nullptr, MERGE, nullptr};
          pg8::gemm_phase<pg8::EpiGate, pg8::StaticOrder, true, true>(lds, g, S, E); }
        asm volatile("s_waitcnt vmcnt(0)" ::: "memory"); __syncthreads();
        { pg8::Gemm g{DIL, WOD, T, DM, 512}; pg8::StaticOrder S; S.init(T, DM, G, bid);
          pg8::EpiGate E{GB, MERGE, nullptr, MERGEB};
          pg8::gemm_phase<pg8::EpiGate, pg8::StaticOrder, true, true>(lds, g, S, E); }
    }
    SEAM(4);
    if (IN(5)) {
        pg8::Gemm g{MERGEB, WOUT, T, DM, DM}; pg8::StaticOrder S; S.init(T, DM, G, bid);
        pg8::EpiResid E{x, X1, X1B, SSQ1};
        pg8::gemm_phase<pg8::EpiResid, pg8::StaticOrder, true, true>(lds, g, S, E);
    }
    SEAM(5);
#pragma unroll 1
    for (int half = 0; half < 2; ++half) {
        const int tile0 = half == 0 ? 0 : UP_TILES_A, ntile = half == 0 ? UP_TILES_A : UP_TILES_B;
        if (IN(6 + 2 * half)) {
            pg8::Gemm g{X1B, WUP + (size_t)tile0 * 256 * DM, T, ntile * 256, DM}; pg8::StaticOrder S; S.init(T, ntile * 256, G, bid);
            pg8::EpiRowScale E{U, U, 1000, ntile * 256, SSQ1, 1.0f / 2048.0f};
            pg8::gemm_phase<pg8::EpiRowScale, pg8::StaticOrder, true, true>(lds, g, S, E);
        }
        SEAM(6 + 2 * half);
        if (IN(7 + 2 * half)) {
            FRESH();
            const int ldu = ntile * 256; const int nitems = (T / 16) * ntile * 16;
            for (int it = gt; it < nitems; it += NGT) {
                const int ch = it & 15, tl = (it >> 4) % ntile, rb = (it >> 4) / ntile; const int t0 = rb * 16;
                const int cu = (tile0 + tl) * 128 + ch * 8, cg_ = DFF + cu;
                float wu[3][8], wg[3][8], bu[8], bg[8];
#pragma unroll
                for (int k = 0; k < 3; ++k)
#pragma unroll
                    for (int j = 0; j < 8; ++j) { wu[k][j] = conv_w[(size_t)k * NUP + cu + j]; wg[k][j] = conv_w[(size_t)k * NUP + cg_ + j]; }
#pragma unroll
                for (int j = 0; j < 8; ++j) { bu[j] = conv_b[cu + j]; bg[j] = conv_b[cg_ + j]; }
                const bf16* up_ = U + (size_t)t0 * ldu + tl * 256 + ch * 8;
                v4u u2 = (v4u){0u, 0u, 0u, 0u}, u1 = u2, g2 = u2, g1 = u2;
                if ((t0 & (SEQ - 1)) != 0) { u2 = *(const v4u*)(up_ - 2 * (size_t)ldu); u1 = *(const v4u*)(up_ - (size_t)ldu); g2 = *(const v4u*)(up_ - 2 * (size_t)ldu + 128); g1 = *(const v4u*)(up_ - (size_t)ldu + 128); }
#pragma unroll 4
                for (int rr = 0; rr < 16; ++rr) {
                    const v4u u0 = *(const v4u*)(up_ + (size_t)rr * ldu), g0 = *(const v4u*)(up_ + (size_t)rr * ldu + 128); v4u o;
#pragma unroll
                    for (int j = 0; j < 4; ++j) {
                        const float ua = bu[2 * j] + wu[0][2 * j] * bflo(u2[j]) + wu[1][2 * j] * bflo(u1[j]) + wu[2][2 * j] * bflo(u0[j]);
                        const float ub = bu[2 * j + 1] + wu[0][2 * j + 1] * bfhi(u2[j]) + wu[1][2 * j + 1] * bfhi(u1[j]) + wu[2][2 * j + 1] * bfhi(u0[j]);
                        const float ga = bg[2 * j] + wg[0][2 * j] * bflo(g2[j]) + wg[1][2 * j] * bflo(g1[j]) + wg[2][2 * j] * bflo(g0[j]);
                        const float gb = bg[2 * j + 1] + wg[0][2 * j + 1] * bfhi(g2[j]) + wg[1][2 * j + 1] * bfhi(g1[j]) + wg[2][2 * j + 1] * bfhi(g0[j]);
                        o[j] = cvt_pk_bf16(ua * ga / (1.0f + __expf(-ga)), ub * gb / (1.0f + __expf(-gb)));
                    }
                    *(v4u*)(ACT + (size_t)(t0 + rr) * DFF + cu) = o;
                    u2 = u1; u1 = u0; g2 = g1; g1 = g0;
                }
            }
        }
        SEAM(7 + 2 * half);
    }
    if (IN(10)) {
        pg8::Gemm g{ACT, WDN, T, DM, DFF}; pg8::StaticOrder S; S.init(T, DM, G, bid);
        pg8::EpiResid E{X1, X1, nullptr, SSQ2};
        pg8::gemm_phase<pg8::EpiResid, pg8::StaticOrder, true, true>(lds, g, S, E);
    }
    SEAM(10);
    if (IN(11)) { FRESH();
        for (int m = gw; m < T; m += NGW) {
            const float rs = rsqrtf(SSQ2[m] * (1.0f / DM) + 1e-6f);
            f32x4* xr = (f32x4*)(out + (size_t)m * DM) + lane; const f32x4* gr = (const f32x4*)final_norm_g + lane;
#pragma unroll
            for (int j = 0; j < 8; ++j) { const f32x4 v = xr[64 * j]; const f32x4 gg = gr[64 * j]; xr[64 * j] = v * rs * gg; }
        }
    }
#undef IN
#undef SEAM
}

#ifndef MK_N_LAUNCHES
#define MK_N_LAUNCHES 1
#endif
extern "C" void kernel_launch(void* const* d_in, const int* in_sizes, int n_in, void* d_out, int out_size, void* d_ws, size_t ws_size, hipStream_t stream) {
    static int grid = 0;
    if (grid == 0) {
        int dev = 0, cus = 0, per_cu = 0;
        if (n_in != 17 || out_size != T * DM || ws_size < WS_END) { fprintf(stderr, "kernel_launch: unexpected shapes / workspace (%d inputs, out %d, ws %zu)\n", n_in, out_size, ws_size); grid = -1; return; }
        (void)hipGetDevice(&dev);
        (void)hipDeviceGetAttribute(&cus, hipDeviceAttributeMultiprocessorCount, dev);
        (void)hipFuncSetAttribute((const void*)fwd_mega, hipFuncAttributeMaxDynamicSharedMemorySize, LDS_BYTES);
        (void)hipOccupancyMaxActiveBlocksPerMultiprocessor(&per_cu, (const void*)fwd_mega, 512, LDS_BYTES);
        if (per_cu < 1) per_cu = 1;
        grid = cus * per_cu;
        if (grid % 8 != 0 || grid < 8) grid = -1;
    }
    if (grid < 0) return;
    Args a{};
    for (int i = 0; i < 17; ++i) a.in[i] = (const float*)d_in[i];
    a.out = (float*)d_out; a.ws = (unsigned char*)d_ws;
#if MK_N_LAUNCHES == 1
    a.ph_lo = 0; a.ph_hi = 12; a.coop = 1;
    void* kargs[] = {&a};
    hipError_t e = hipLaunchCooperativeKernel((const void*)fwd_mega, dim3(grid), dim3(512), kargs, LDS_BYTES, stream);
    if (e != hipSuccess) fprintf(stderr, "cooperative launch failed: %s (grid %d)\n", hipGetErrorString(e), grid);
#else
    for (int p = 0; p < 12; ++p) { a.ph_lo = p; a.ph_hi = p + 1; a.coop = 0; hipLaunchKernelGGL(fwd_mega, dim3(grid), dim3(512), LDS_BYTES, stream, a); }
#endif
}
```

```cpp
#include <hip/hip_runtime.h>
#include <hip/hip_cooperative_groups.h>
#include <cstdio>
#include <cstdint>
namespace cg = cooperative_groups;
namespace pg8 {
#define PG8_LAS __attribute__((address_space(3)))
typedef unsigned short bf16_t;
typedef short bf16x8 __attribute__((ext_vector_type(8)));
typedef float f32x4 __attribute__((ext_vector_type(4)));
typedef unsigned u32x4 __attribute__((ext_vector_type(4)));
constexpr int BM = 256, BK = 64, HALF = 128, HTB = HALF * BK * 2  , STAGE_BYTES = 8 * HTB, NXCD = 8, WGM = 8;

__host__ __device__ __forceinline__ int lds_byte(int r, int c) { const int st = (r >> 4) * 2 + (c >> 5), rr = r & 15, cc = c & 31, ob = rr * 64 + cc * 2; return st * 1024 + (ob ^ (((ob >> 9) & 1) << 5)); }
__host__ __device__ __forceinline__ void stage_rc(int b, int& R, int& C) { const int st = b / 1024, sb = b % 1024, swz = sb ^ (((sb >> 9) & 1) << 5); R = (st >> 1) * 16 + swz / 64; C = (st & 1) * 32 + (swz % 64) / 2; }
__host__ __device__ __forceinline__ int perm32(int rho) { const int n = rho >> 4, i = rho & 15; return 8 * (i >> 2) + 4 * n + (i & 3); }

struct Unit { int pm, pn; };
struct Gemm { const bf16_t* A; const bf16_t* Bt; int M, N, K; };

struct StaticOrder {
    int nM, nN, nwg, G, c;
    __host__ __device__ void init(int M, int N, int G_, int c_) { nM = M / BM; nN = N / BM; nwg = nM * nN; G = G_; c = c_; }
    __host__ __device__ bool next(int i, Unit& u) const {
        const long L = (long)i * G + c; if (L >= nwg) return false;
        int wgid = (int)L; { const int q = nwg / NXCD, r = nwg % NXCD, xcd = wgid % NXCD, off = wgid / NXCD; wgid = (xcd < r ? xcd * (q + 1) : r * (q + 1) + (xcd - r) * q) + off; }
        const int nig = WGM * nN, gid = wgid / nig, fm = gid * WGM, gsz = (nM - fm) < WGM ? (nM - fm) : WGM;
        u.pm = fm + ((wgid % nig) % gsz); u.pn = (wgid % nig) / gsz; return true;
    }
    __device__ __forceinline__ void a_ready(const Unit&) const {}
    __device__ __forceinline__ void done(const Unit&) const {}
};

__device__ __forceinline__ unsigned cvt_pk_bf16(float lo, float hi) { unsigned r; asm volatile("v_cvt_pk_bf16_f32 %0, %1, %2" : "=v"(r) : "v"(lo), "v"(hi)); return r; }
typedef float f32x2 __attribute__((ext_vector_type(2)));
typedef unsigned u32x2 __attribute__((ext_vector_type(2)));
constexpr float NORM_EPS_F = 1e-6f;
__device__ __forceinline__ float bf_lo(unsigned w) { return __uint_as_float(w << 16); }
__device__ __forceinline__ float bf_hi(unsigned w) { return __uint_as_float(w & 0xffff0000u); }
__device__ __forceinline__ u32x4 pack8(const f32x4 a, const f32x4 b) { u32x4 w; w.x = cvt_pk_bf16(a[0], a[1]); w.y = cvt_pk_bf16(a[2], a[3]); w.z = cvt_pk_bf16(b[0], b[1]); w.w = cvt_pk_bf16(b[2], b[3]); return w; }
__device__ __forceinline__ float sq8(const f32x4 a, const f32x4 b) { return (a[0] * a[0] + a[1] * a[1]) + (a[2] * a[2] + a[3] * a[3]) + (b[0] * b[0] + b[1] * b[1]) + (b[2] * b[2] + b[3] * b[3]); }
__device__ __forceinline__ float sigm(float v) { return 1.0f / (1.0f + __expf(-v)); }

struct EpiProj {
    static constexpr bool PERM = true, AFTER_DRAIN = false;
    bf16_t *CQ, *CKV, *DQ, *DK, *DV, *GA, *GB; float* KPER; const float* rstd0; float *ssq_q, *ssq_kv; const float* b_gate;
    __device__ __forceinline__ void operator()(const f32x4 (&acc)[2][2][4][2], const Unit& u, int wr, int wc, int fr, int fq) const {
        const int pn = u.pn; const int row0 = u.pm * BM + wr * 64 + fr; const int cw = wc * 32 + 8 * fq;
        bf16_t* base = CQ; int ldc = 512, c0 = 0; const float* bias = nullptr; float* ssq = nullptr;
        if (pn < 2) { base = CQ; ldc = 512; c0 = pn * 256; ssq = ssq_q; }
        else if (pn == 2) { base = CKV; ldc = 256; c0 = 0; ssq = ssq_kv; }
        else if (pn == 3) { base = nullptr; }
        else if (pn < 10) { base = DQ; ldc = 1536; c0 = (pn - 4) * 256; }
        else if (pn < 16) { base = DK; ldc = 1536; c0 = (pn - 10) * 256; }
        else if (pn < 22) { base = DV; ldc = 1536; c0 = (pn - 16) * 256; }
        else if (pn < 30) { base = GA; ldc = 2048; c0 = (pn - 22) * 256; bias = b_gate + c0; }
        else { base = GB; ldc = 2048; c0 = (pn - 30) * 256; bias = b_gate + 2048 + c0; }
        if (base == nullptr) {
            if (wc < 2) {
#pragma unroll
                for (int ai = 0; ai < 2; ++ai)
#pragma unroll
                    for (int m = 0; m < 4; ++m) { const int row = row0 + ai * HALF + m * 16; const float rs = rstd0[row];
                        float* p = KPER + (size_t)row * 64 + cw; *(f32x4*)p = acc[ai][0][m][0] * rs; *(f32x4*)(p + 4) = acc[ai][0][m][1] * rs; }
            }
            return;
        }
        f32x4 bv[2][2];
#pragma unroll
        for (int bj = 0; bj < 2; ++bj)
#pragma unroll
            for (int n = 0; n < 2; ++n) bv[bj][n] = bias ? *(const f32x4*)(bias + bj * HALF + cw + 4 * n) : (f32x4){0.f, 0.f, 0.f, 0.f};
#pragma unroll
        for (int ai = 0; ai < 2; ++ai)
#pragma unroll
            for (int m = 0; m < 4; ++m) { const int row = row0 + ai * HALF + m * 16; const float rs = rstd0[row]; bf16_t* rowp = base + (size_t)row * ldc + c0 + cw; float s = 0.f;
#pragma unroll
                for (int bj = 0; bj < 2; ++bj) { f32x4 v0 = acc[ai][bj][m][0] * rs, v1 = acc[ai][bj][m][1] * rs;
                    if (bias) { v0 = v0 + bv[bj][0]; v1 = v1 + bv[bj][1];
#pragma unroll
                        for (int e = 0; e < 4; ++e) { v0[e] = sigm(v0[e]); v1[e] = sigm(v1[e]); } }
                    s += sq8(v0, v1);
                    *(u32x4*)(rowp + bj * HALF) = pack8(v0, v1); }
                if (ssq) { s += __shfl_xor(s, 16); s += __shfl_xor(s, 32); if (fq == 0) atomicAdd(ssq + row, s); } }
    }
};

struct EpiRowScale {
    static constexpr bool PERM = true, AFTER_DRAIN = false;
    bf16_t *O0, *O1; int split, ldc; const float* ssq; float inv_dim;
    __device__ __forceinline__ void operator()(const f32x4 (&acc)[2][2][4][2], const Unit& u, int wr, int wc, int fr, int fq) const {
        const int pn = u.pn; const int row0 = u.pm * BM + wr * 64 + fr; const int cw = wc * 32 + 8 * fq;
        bf16_t* base = pn < split ? O0 : O1; const int c0 = (pn < split ? pn : pn - split) * 256;
#pragma unroll
        for (int ai = 0; ai < 2; ++ai)
#pragma unroll
            for (int m = 0; m < 4; ++m) { const int row = row0 + ai * HALF + m * 16; const float rs = rsqrtf(ssq[row] * inv_dim + NORM_EPS_F); bf16_t* rowp = base + (size_t)row * ldc + c0 + cw;
#pragma unroll
                for (int bj = 0; bj < 2; ++bj) *(u32x4*)(rowp + bj * HALF) = pack8(acc[ai][bj][m][0] * rs, acc[ai][bj][m][1] * rs); }
    }
};

struct EpiGate {
    static constexpr bool PERM = true, AFTER_DRAIN = false;
    const bf16_t* G; const float* addin; float* outf; bf16_t* outb;
    __device__ __forceinline__ void operator()(const f32x4 (&acc)[2][2][4][2], const Unit& u, int wr, int wc, int fr, int fq) const {
        const int row0 = u.pm * BM + wr * 64 + fr; const int col0 = u.pn * BM + wc * 32 + 8 * fq;
#pragma unroll
        for (int ai = 0; ai < 2; ++ai)
#pragma unroll
            for (int m = 0; m < 4; ++m) { const size_t off = (size_t)(row0 + ai * HALF + m * 16) * 2048 + col0;
#pragma unroll
                for (int bj = 0; bj < 2; ++bj) { const u32x4 g = *(const u32x4*)(G + off + bj * HALF);
                    f32x4 v0 = acc[ai][bj][m][0] * (f32x4){bf_lo(g.x), bf_hi(g.x), bf_lo(g.y), bf_hi(g.y)};
                    f32x4 v1 = acc[ai][bj][m][1] * (f32x4){bf_lo(g.z), bf_hi(g.z), bf_lo(g.w), bf_hi(g.w)};
                    if (addin) { v0 = v0 + *(const f32x4*)(addin + off + bj * HALF); v1 = v1 + *(const f32x4*)(addin + off + bj * HALF + 4); }
                    if (outf) { *(f32x4*)(outf + off + bj * HALF) = v0; *(f32x4*)(outf + off + bj * HALF + 4) = v1; }
                    if (outb) *(u32x4*)(outb + off + bj * HALF) = pack8(v0, v1); } }
    }
};

struct EpiResid {
    static constexpr bool PERM = true, AFTER_DRAIN = false;
    const float* resid; float* outf; bf16_t* outb; float* ssq;
    __device__ __forceinline__ void operator()(const f32x4 (&acc)[2][2][4][2], const Unit& u, int wr, int wc, int fr, int fq) const {
        const int row0 = u.pm * BM + wr * 64 + fr; const int col0 = u.pn * BM + wc * 32 + 8 * fq;
#pragma unroll
        for (int ai = 0; ai < 2; ++ai)
#pragma unroll
            for (int m = 0; m < 4; ++m) { const int row = row0 + ai * HALF + m * 16; const size_t off = (size_t)row * 2048 + col0; float s = 0.f;
#pragma unroll
                for (int bj = 0; bj < 2; ++bj) { const f32x4 v0 = acc[ai][bj][m][0] + *(const f32x4*)(resid + off + bj * HALF), v1 = acc[ai][bj][m][1] + *(const f32x4*)(resid + off + bj * HALF + 4);
                    s += sq8(v0, v1);
                    *(f32x4*)(outf + off + bj * HALF) = v0; *(f32x4*)(outf + off + bj * HALF + 4) = v1;
                    if (outb) *(u32x4*)(outb + off + bj * HALF) = pack8(v0, v1); }
                s += __shfl_xor(s, 16); s += __shfl_xor(s, 32); if (fq == 0) atomicAdd(ssq + row, s); }
    }
};

template <class Epi, class Sched, bool ALIGN_EPI = false, bool SP2 = false>
__device__ __forceinline__ void gemm_phase(PG8_LAS unsigned char* lds, const Gemm g, const Sched& S, const Epi& E) {
    int tid_ = threadIdx.x; asm volatile("" : "+v"(tid_));
    const int tid = tid_, wid = __builtin_amdgcn_readfirstlane(tid >> 6), lane = tid & 63, wr = wid >> 2, wc = wid & 3, fr = lane & 15, fq = lane >> 4;
    const int K = g.K, nt = K / BK;
    unsigned voffA[2], voffB[2];
#pragma unroll
    for (int i = 0; i < 2; ++i) { int R, C; stage_rc(tid * 16 + i * 8192, R, C); const int Rb = Epi::PERM ? ((R & ~31) + perm32(R & 31)) : R;
        voffA[i] = (unsigned)(R * K + C) * 2u; voffB[i] = (unsigned)(Rb * K + C) * 2u; }
    const size_t kstep = (size_t)(BK * 2);
    const size_t hstep = (size_t)HALF * K * 2;
    const size_t tstep = 2 * hstep;
    const unsigned ldsw = (unsigned)wid * 1024u;
    const int aoff = lds_byte(wr * 64 + fr, fq * 8), boff = lds_byte(wc * 32 + fr, fq * 8);
#define PG8_SA(b, h) (((b) * 2 + (h)) * HTB)
#define PG8_SB(b, h) ((4 + (b) * 2 + (h)) * HTB)
#define PG8_STAGE(bufoff, gbase, voff) do { _Pragma("unroll") for (int _i = 0; _i < 2; ++_i) \
        __builtin_amdgcn_global_load_lds((const unsigned*)((const char*)(gbase) + (voff)[_i]), (PG8_LAS unsigned*)(lds + (bufoff) + ldsw + _i * 8192), 16, 0, 0); } while (0)
#define PG8_LDA(dst, b, h) do { _Pragma("unroll") for (int m = 0; m < 4; ++m) _Pragma("unroll") for (int k = 0; k < 2; ++k) dst[m][k] = *(const PG8_LAS bf16x8*)(lds + PG8_SA(b, h) + aoff + m * 2048 + k * 1024); } while (0)
#define PG8_LDB(dst, b, h) do { _Pragma("unroll") for (int n = 0; n < 2; ++n) _Pragma("unroll") for (int k = 0; k < 2; ++k) dst[n][k] = *(const PG8_LAS bf16x8*)(lds + PG8_SB(b, h) + boff + n * 2048 + k * 1024); } while (0)
#define PG8_MMA(ai, bj, At, Bt) do { __builtin_amdgcn_s_setprio(1); _Pragma("unroll") for (int m = 0; m < 4; ++m) _Pragma("unroll") for (int n = 0; n < 2; ++n) _Pragma("unroll") for (int k = 0; k < 2; ++k) \
        acc[ai][bj][m][n] = __builtin_amdgcn_mfma_f32_16x16x32_bf16(Bt[n][k], At[m][k], acc[ai][bj][m][n], 0, 0, 0); __builtin_amdgcn_s_setprio(0); } while (0)
#define PG8_WAIT_V(n) asm volatile("s_waitcnt vmcnt(" #n ")" ::: "memory")
#define PG8_WAIT_L(n) asm volatile("s_waitcnt lgkmcnt(" #n ")" ::: "memory")
#define PG8_BAR __builtin_amdgcn_s_barrier()
#define PG8_SCHED __builtin_amdgcn_sched_barrier(0)
    Unit cur, nxt; int ui = 0;
    if (!S.next(0, cur)) return;
    f32x4 acc[2][2][4][2];
#pragma unroll
    for (int a = 0; a < 2; ++a)
#pragma unroll
        for (int b = 0; b < 2; ++b)
#pragma unroll
            for (int m = 0; m < 4; ++m)
#pragma unroll
                for (int n = 0; n < 2; ++n) acc[a][b][m][n] = (f32x4){0.f, 0.f, 0.f, 0.f};
    bf16x8 At[4][2], B0[2][2], B1[2][2];
    const char* cA = (const char*)g.A + (size_t)cur.pm * tstep; const char* cB = (const char*)g.Bt + (size_t)cur.pn * tstep;
    S.a_ready(cur);
    if constexpr (SP2) {
        PG8_STAGE(PG8_SB(0, 0), cB, voffB); PG8_STAGE(PG8_SB(0, 1), cB + hstep, voffB); PG8_STAGE(PG8_SA(0, 0), cA, voffA); PG8_STAGE(PG8_SA(0, 1), cA + hstep, voffA);
        if (wr == 1) PG8_BAR;
        PG8_WAIT_V(2); PG8_BAR;
        PG8_STAGE(PG8_SB(1, 0), cB + kstep, voffB); PG8_STAGE(PG8_SA(1, 0), cA + kstep, voffA); PG8_STAGE(PG8_SB(1, 1), cB + hstep + kstep, voffB);
        PG8_WAIT_V(6); PG8_BAR;
    } else {
        PG8_STAGE(PG8_SB(0, 0), cB, voffB); PG8_STAGE(PG8_SA(0, 0), cA, voffA); PG8_STAGE(PG8_SB(0, 1), cB + hstep, voffB); PG8_STAGE(PG8_SA(0, 1), cA + hstep, voffA);
        if (wr == 1) PG8_BAR;
        PG8_WAIT_V(4); PG8_BAR;
        PG8_STAGE(PG8_SB(1, 0), cB + kstep, voffB); PG8_STAGE(PG8_SA(1, 0), cA + kstep, voffA); PG8_STAGE(PG8_SB(1, 1), cB + hstep + kstep, voffB);
        PG8_WAIT_V(6); PG8_BAR;
    }
    for (;;) {
        const bool has_next = S.next(ui + 1, nxt);
        const char* nA = has_next ? (const char*)g.A + (size_t)nxt.pm * tstep : cA; const char* nB = has_next ? (const char*)g.Bt + (size_t)nxt.pn * tstep : cB;
        for (int t = 0; t < nt; t += 2) {
            const bool last = (t == nt - 2);
            const char* a1 = cA + (size_t)(t + 1) * kstep;
            const char* a2 = last ? nA : cA + (size_t)(t + 2) * kstep; const char* b2 = last ? nB : cB + (size_t)(t + 2) * kstep;
            const char* a3 = a2 + kstep; const char* b3 = b2 + kstep;
            if (last && has_next) S.a_ready(nxt);
            if constexpr (SP2) {
            PG8_LDB(B0, 0, 0); PG8_LDB(B1, 0, 1); PG8_SCHED; PG8_LDA(At, 0, 0); PG8_STAGE(PG8_SA(1, 1), a1 + hstep, voffA);
            PG8_WAIT_V(8); PG8_WAIT_L(0); PG8_BAR; PG8_MMA(0, 0, At, B0); PG8_MMA(0, 1, At, B1); PG8_BAR; PG8_SCHED;
            PG8_LDA(At, 0, 1); PG8_STAGE(PG8_SB(0, 0), b2, voffB); PG8_STAGE(PG8_SB(0, 1), b2 + hstep, voffB); PG8_STAGE(PG8_SA(0, 0), a2, voffA);
            PG8_WAIT_V(8); PG8_WAIT_L(0); PG8_BAR; PG8_MMA(1, 0, At, B0); PG8_MMA(1, 1, At, B1); PG8_BAR; PG8_SCHED;
            PG8_LDB(B0, 1, 0); PG8_LDB(B1, 1, 1); PG8_SCHED; PG8_LDA(At, 1, 0); PG8_STAGE(PG8_SA(0, 1), a2 + hstep, voffA);
            PG8_WAIT_V(8); PG8_WAIT_L(0); PG8_BAR; PG8_MMA(0, 0, At, B0); PG8_MMA(0, 1, At, B1); PG8_BAR; PG8_SCHED;
            PG8_LDA(At, 1, 1); PG8_STAGE(PG8_SB(1, 0), b3, voffB); PG8_STAGE(PG8_SB(1, 1), b3 + hstep, voffB); PG8_STAGE(PG8_SA(1, 0), a3, voffA);
            PG8_WAIT_V(8); PG8_WAIT_L(0); PG8_BAR; PG8_MMA(1, 0, At, B0); PG8_MMA(1, 1, At, B1); PG8_BAR; PG8_SCHED;
            } else {
            PG8_LDB(B0, 0, 0); PG8_SCHED; PG8_LDA(At, 0, 0); PG8_STAGE(PG8_SA(1, 1), a1 + hstep, voffA);
            PG8_WAIT_L(8); PG8_BAR; PG8_WAIT_L(0); PG8_MMA(0, 0, At, B0); PG8_BAR; PG8_SCHED;
            PG8_LDB(B1, 0, 1); PG8_STAGE(PG8_SB(0, 0), b2, voffB);
            PG8_BAR; PG8_WAIT_L(0); PG8_MMA(0, 1, At, B1); PG8_BAR;
            PG8_LDA(At, 0, 1); PG8_STAGE(PG8_SA(0, 0), a2, voffA);
            PG8_BAR; PG8_WAIT_L(0); PG8_MMA(1, 0, At, B0); PG8_BAR; PG8_SCHED;
            PG8_STAGE(PG8_SB(0, 1), b2 + hstep, voffB);
            PG8_WAIT_V(6); PG8_BAR; PG8_MMA(1, 1, At, B1); PG8_BAR;
            PG8_LDB(B0, 1, 0); PG8_SCHED; PG8_LDA(At, 1, 0); PG8_STAGE(PG8_SA(0, 1), a2 + hstep, voffA);
            PG8_WAIT_L(8); PG8_BAR; PG8_WAIT_L(0); PG8_MMA(0, 0, At, B0); PG8_BAR; PG8_SCHED;
            PG8_LDB(B1, 1, 1); PG8_STAGE(PG8_SB(1, 0), b3, voffB);
            PG8_BAR; PG8_WAIT_L(0); PG8_MMA(0, 1, At, B1); PG8_BAR;
            PG8_LDA(At, 1, 1); PG8_STAGE(PG8_SA(1, 0), a3, voffA);
            PG8_BAR; PG8_WAIT_L(0); PG8_MMA(1, 0, At, B0); PG8_BAR; PG8_SCHED;
            PG8_STAGE(PG8_SB(1, 1), b3 + hstep, voffB);
            PG8_WAIT_V(6); PG8_BAR; PG8_MMA(1, 1, At, B1); PG8_BAR;
            }
        }
        if constexpr (ALIGN_EPI) { if (wr == 0) PG8_BAR; }
        if constexpr (!Epi::AFTER_DRAIN) { E(acc, cur, wr, wc, fr, fq); S.done(cur); }
        if (!has_next) break;
#pragma unroll
        for (int a = 0; a < 2; ++a)
#pragma unroll
            for (int b = 0; b < 2; ++b)
#pragma unroll
                for (int m = 0; m < 4; ++m)
#pragma unroll
                    for (int n = 0; n < 2; ++n) acc[a][b][m][n] = (f32x4){0.f, 0.f, 0.f, 0.f};
        cur = nxt; cA = nA; cB = nB; ++ui;
        if constexpr (ALIGN_EPI) { if (wr == 1) PG8_BAR; }
    }
    PG8_WAIT_V(0);
    if constexpr (!ALIGN_EPI) { if (wr == 0) PG8_BAR; }
    PG8_BAR;
    if constexpr (Epi::AFTER_DRAIN) { E.fused(acc, cur, wr, wc, fr, fq, lds, wid, lane); S.done(cur); }
#undef PG8_SA
#undef PG8_SB
#undef PG8_STAGE
#undef PG8_LDA
#undef PG8_LDB
#undef PG8_MMA
#undef PG8_WAIT_V
#undef PG8_WAIT_L
#undef PG8_BAR
#undef PG8_SCHED
}
}
#define LAS __attribute__((address_space(3)))
typedef unsigned short bf16;
typedef float f32x4 __attribute__((ext_vector_type(4)));
typedef float f32x2v __attribute__((ext_vector_type(2)));
typedef float f32x16 __attribute__((ext_vector_type(16)));
typedef unsigned v4u __attribute__((ext_vector_type(4)));
typedef unsigned v2u __attribute__((ext_vector_type(2)));
typedef short bf16x8 __attribute__((ext_vector_type(8)));
using pg8::cvt_pk_bf16;
__device__ __forceinline__ float bflo(unsigned w) { return __uint_as_float(w << 16); }
__device__ __forceinline__ float bfhi(unsigned w) { return __uint_as_float(w & 0xffff0000u); }
__device__ __forceinline__ float wave_sum(float v) {
#pragma unroll
    for (int o = 1; o < 64; o <<= 1) v += __shfl_xor(v, o);
    return v;
}

constexpr int VT_STR = 144;
template <int DQK, bool ROPEQ>
__device__ __forceinline__ void attn_unit(LAS unsigned char* lds,
        const bf16* Qb, long q_pitch, const bf16* Kb, long k_pitch, const bf16* Kpe, long kpe_pitch, const bf16* Vb, long v_pitch,
        bf16* Ob, long o_pitch, float* lse, long lse_pitch, int q0, int W, float sc2, float slope2, const f32x2v* rope) {
    constexpr int KSTR = DQK * 2 + 16;
    constexpr int ND0 = DQK / 16;
    LAS unsigned char* Kt = lds;
    LAS unsigned char* Vt = lds + 64 * KSTR;
    int tid_ = threadIdx.x; asm volatile("" : "+v"(tid_));
    const int tid = tid_, lane = tid & 63, r32 = lane & 31, hi = lane >> 5; const int wid = __builtin_amdgcn_readfirstlane(tid >> 6);
    const int qlo = q0 + 32 * wid, qrow = qlo + r32;
    bf16x8 qf[ND0];
    { const bf16* qp = Qb + (long)qrow * q_pitch + 8 * hi;
#pragma unroll
      for (int d0 = 0; d0 < ND0; ++d0) qf[d0] = *(const bf16x8*)(qp + 16 * d0); }
    if constexpr (ROPEQ) {
#pragma unroll
        for (int dp = 0; dp < 2; ++dp) {
            const f32x2v* rp = rope + (long)qrow * 32 + 16 * dp + 8 * hi;
            bf16x8 x1 = qf[8 + dp], x2 = qf[10 + dp]; bf16x8 y1, y2;
#pragma unroll
            for (int j = 0; j < 8; j += 2) {
                const f32x2v cs0 = rp[j], cs1 = rp[j + 1];
                const float a0 = __uint_as_float(((unsigned)(unsigned short)x1[j]) << 16), a1 = __uint_as_float(((unsigned)(unsigned short)x1[j + 1]) << 16);
                const float b0 = __uint_as_float(((unsigned)(unsigned short)x2[j]) << 16), b1 = __uint_as_float(((unsigned)(unsigned short)x2[j + 1]) << 16);
                const unsigned w1 = cvt_pk_bf16(a0 * cs0.x - b0 * cs0.y, a1 * cs1.x - b1 * cs1.y);
                const unsigned w2 = cvt_pk_bf16(b0 * cs0.x + a0 * cs0.y, b1 * cs1.x + a1 * cs1.y);
                y1[j] = (short)(w1 & 0xffffu); y1[j + 1] = (short)(w1 >> 16); y2[j] = (short)(w2 & 0xffffu); y2[j + 1] = (short)(w2 >> 16);
            }
            qf[8 + dp] = y1; qf[10 + dp] = y2;
        }
    }
    f32x16 o[4];
#pragma unroll
    for (int i = 0; i < 4; ++i) o[i] = f32x16{};
    float m_run = -1e30f, l_run = 0.f;
    const int kt_hi = (q0 >> 6) + 3; int kt_lo = (q0 - W) >> 6; if (kt_lo < 0) kt_lo = 0;
    const int kr0 = tid >> 4, kc0 = tid & 15;
    const int pr = tid >> 3, pc = tid & 7;
    const int vc0 = wid, vc1 = wid + 8;
    v4u kreg0, kreg1, preg = (v4u){0u, 0u, 0u, 0u}, vreg0, vreg1;
    const unsigned koff0 = (unsigned)((kr0 * k_pitch + 8 * kc0) * 2), koff1 = (unsigned)(((kr0 + 32) * k_pitch + 8 * kc0) * 2), poff = (unsigned)((pr * kpe_pitch + 8 * pc) * 2);
    const unsigned voff0 = (unsigned)((lane * v_pitch + 8 * vc0) * 2), voff1 = voff0 + 128u;
#define ATT_LOAD(kt) do { const char* kb_ = (const char*)Kb + (size_t)(kt) * 128 * (size_t)k_pitch; const char* vb_ = (const char*)Vb + (size_t)(kt) * 128 * (size_t)v_pitch; \
        kreg0 = *(const v4u*)(kb_ + koff0); kreg1 = *(const v4u*)(kb_ + koff1); \
        if constexpr (DQK == 192) { const char* pb_ = (const char*)Kpe + (size_t)(kt) * 128 * (size_t)kpe_pitch; preg = *(const v4u*)(pb_ + poff); } \
        vreg0 = *(const v4u*)(vb_ + voff0); vreg1 = *(const v4u*)(vb_ + voff1); } while (0)
    ATT_LOAD(kt_lo);
    const int pir = (r32 & ~12) | ((r32 & 4) << 1) | ((r32 & 8) >> 1);
    const LAS unsigned char* kread = Kt + pir * KSTR + hi * 16;
    const LAS unsigned char* vread = Vt + r32 * VT_STR + hi * 16;
    for (int kt = kt_lo; kt <= kt_hi; ++kt) {
        __syncthreads();
        *(LAS v4u*)(Kt + kr0 * KSTR + kc0 * 16) = kreg0; *(LAS v4u*)(Kt + (kr0 + 32) * KSTR + kc0 * 16) = kreg1;
        if constexpr (DQK == 192) *(LAS v4u*)(Kt + pr * KSTR + 256 + pc * 16) = preg;
        {
            LAS unsigned short* v0p = (LAS unsigned short*)(Vt + (8 * vc0) * VT_STR + lane * 2);
            LAS unsigned short* v1p = (LAS unsigned short*)(Vt + (8 * vc1) * VT_STR + lane * 2);
#pragma unroll
            for (int j = 0; j < 4; ++j) {
                v0p[(2 * j) * (VT_STR / 2)] = (unsigned short)(vreg0[j] & 0xffffu); v0p[(2 * j + 1) * (VT_STR / 2)] = (unsigned short)(vreg0[j] >> 16);
                v1p[(2 * j) * (VT_STR / 2)] = (unsigned short)(vreg1[j] & 0xffffu); v1p[(2 * j + 1) * (VT_STR / 2)] = (unsigned short)(vreg1[j] >> 16);
            }
        }
        if (kt < kt_hi) ATT_LOAD(kt + 1);
        __syncthreads();
        const int k0 = kt * 64;
        if (k0 > qlo + 31 || k0 + 63 < qlo - W) continue;
        f32x16 p0 = f32x16{}, p1 = f32x16{};
#pragma unroll
        for (int d0 = 0; d0 < ND0; ++d0) {
            const bf16x8 a0 = *(const LAS bf16x8*)(kread + d0 * 32), a1 = *(const LAS bf16x8*)(kread + 32 * KSTR + d0 * 32);
            p0 = __builtin_amdgcn_mfma_f32_32x32x16_bf16(a0, qf[d0], p0, 0, 0, 0);
            p1 = __builtin_amdgcn_mfma_f32_32x32x16_bf16(a1, qf[d0], p1, 0, 0, 0);
        }
        const bool need_mask = (k0 + 63 > qlo) || (k0 < qlo + 31 - W);
        const int dbase = qrow - k0 - 8 * hi;
        float mx = -INFINITY;
#pragma unroll
        for (int r = 0; r < 16; ++r) {
            const int d0_ = dbase - 16 * (r >> 3) - (r & 7), d1_ = d0_ - 32;
            float s0 = p0[r] * sc2 - slope2 * (float)d0_, s1 = p1[r] * sc2 - slope2 * (float)d1_;
            if (need_mask) { if (d0_ < 0 || d0_ > W) s0 = -INFINITY; if (d1_ < 0 || d1_ > W) s1 = -INFINITY; }
            p0[r] = s0; p1[r] = s1; mx = fmaxf(mx, fmaxf(s0, s1));
        }
        mx = fmaxf(mx, __shfl_xor(mx, 32));
        const float m_new = fmaxf(m_run, mx), alpha = __builtin_amdgcn_exp2f(m_run - m_new);
        m_run = m_new;
        float rs = 0.f;
#pragma unroll
        for (int r = 0; r < 16; ++r) { p0[r] = __builtin_amdgcn_exp2f(p0[r] - m_new); p1[r] = __builtin_amdgcn_exp2f(p1[r] - m_new); rs += p0[r] + p1[r]; }
        l_run = l_run * alpha + rs;
#pragma unroll
        for (int i = 0; i < 4; ++i)
#pragma unroll
            for (int r = 0; r < 16; ++r) o[i][r] *= alpha;
        bf16x8 pf[4];
#pragma unroll
        for (int s = 0; s < 2; ++s) {
            v4u w0, w1;
            w0.x = cvt_pk_bf16(p0[8 * s + 0], p0[8 * s + 1]); w0.y = cvt_pk_bf16(p0[8 * s + 2], p0[8 * s + 3]); w0.z = cvt_pk_bf16(p0[8 * s + 4], p0[8 * s + 5]); w0.w = cvt_pk_bf16(p0[8 * s + 6], p0[8 * s + 7]);
            w1.x = cvt_pk_bf16(p1[8 * s + 0], p1[8 * s + 1]); w1.y = cvt_pk_bf16(p1[8 * s + 2], p1[8 * s + 3]); w1.z = cvt_pk_bf16(p1[8 * s + 4], p1[8 * s + 5]); w1.w = cvt_pk_bf16(p1[8 * s + 6], p1[8 * s + 7]);
            pf[s] = __builtin_bit_cast(bf16x8, w0); pf[2 + s] = __builtin_bit_cast(bf16x8, w1);
        }
#pragma unroll
        for (int db = 0; db < 4; ++db)
#pragma unroll
            for (int s = 0; s < 4; ++s) {
                const bf16x8 vf = *(const LAS bf16x8*)(vread + db * 32 * VT_STR + s * 32);
                o[db] = __builtin_amdgcn_mfma_f32_32x32x16_bf16(vf, pf[s], o[db], 0, 0, 0);
            }
    }
#undef ATT_LOAD
    const float l_tot = l_run + __shfl_xor(l_run, 32), inv = 1.0f / l_tot;
    bf16* op = Ob + (long)qrow * o_pitch + 4 * hi;
#pragma unroll
    for (int db = 0; db < 4; ++db)
#pragma unroll
        for (int g = 0; g < 4; ++g) { v2u w; w.x = cvt_pk_bf16(o[db][4 * g] * inv, o[db][4 * g + 1] * inv); w.y = cvt_pk_bf16(o[db][4 * g + 2] * inv, o[db][4 * g + 3] * inv);
            *(v2u*)(op + 32 * db + 8 * g) = w; }
    if (lse != nullptr && hi == 0) lse[(long)qrow * lse_pitch] = (m_run + __builtin_amdgcn_logf(l_tot)) * 0.6931471805599453f;
}
constexpr int T = 16384, SEQ = 4096, DM = 2048, DFF = 5504, NUP = 2 * DFF;
constexpr int N_IN_PAD = 9728;
constexpr int UP_TILES_A = 24, UP_TILES_B = 19;
constexpr size_t MiB = 1u << 20;
constexpr size_t WS_RSTD0 = 0, WS_SSQQ = 65536, WS_SSQKV = 2 * 65536, WS_SSQ1 = 3 * 65536, WS_SSQ2 = 4 * 65536;
constexpr size_t WS_LSE = 1 * MiB;
constexpr size_t WS_ROPE = 2 * MiB;
constexpr size_t WS_WUQ = 3 * MiB;
constexpr size_t WS_WKV = WS_WUQ + 1536 * 512 * 2;
constexpr size_t WS_WOM = WS_WKV + 2048 * 256 * 2;
constexpr size_t WS_WOD = WS_WOM + 2048 * 1024 * 2;
constexpr size_t WS_WOUT = WS_WOD + 2048 * 512 * 2;
constexpr size_t WS_A = 19 * MiB + 512 * 1024;
constexpr size_t WS_C = 83 * MiB + 512 * 1024;
constexpr size_t WS_WIN = WS_C, WS_V = WS_C;
constexpr size_t WS_CQ = 122 * MiB, WS_CKV = 138 * MiB, WS_KPER = 146 * MiB;
constexpr size_t WS_WDN = WS_C, WS_WUP = WS_WDN + (size_t)DM * DFF * 2;
constexpr size_t WS_E = 150 * MiB;
constexpr size_t WS_DQ = WS_E, WS_DK = WS_E + 48 * MiB, WS_DV = WS_E + 96 * MiB;
constexpr size_t WS_ATT = WS_E, WS_DIL = WS_E + 32 * MiB;
constexpr size_t WS_GA = 294 * MiB, WS_GB = 358 * MiB;
constexpr size_t WS_G = 422 * MiB;
constexpr size_t WS_Q = WS_G, WS_KN = WS_G + 48 * MiB, WS_KPE = WS_G + 80 * MiB, WS_MERGEB = WS_G;
constexpr size_t WS_U = 148 * MiB;
constexpr size_t WS_ACT = 340 * MiB;
constexpr size_t WS_END = 512 * MiB;
static_assert(WS_WOUT + (size_t)DM * DM * 2 <= WS_A && WS_A + 64 * MiB <= WS_C && WS_C + 38 * MiB <= WS_CQ, "small weights / A / C");
static_assert(WS_WUP + (size_t)NUP * DM * 2 <= WS_U, "wup");
static_assert((size_t)T * UP_TILES_A * 256 * 2 == 192 * MiB, "U");
constexpr size_t WS_ACT_REAL = WS_U + 192 * MiB;
static_assert(WS_ACT_REAL + (size_t)T * DFF * 2 <= WS_END, "ACT must fit");

struct Args { const float* in[17]; float* out; unsigned char* ws; int ph_lo, ph_hi, coop, pad; };

__device__ __forceinline__ int map_row(int code, int n) {
    switch (code) {
        case 1: return n < 832 ? n : n + 192;
        case 2: { const int h = n >> 8, j = n & 255; return j < 128 ? h * 128 + j : 1024 + h * 128 + (j - 128); }
        case 3: { const int gate = n >= DFF ? 1 : 0, c = n - gate * DFF; return (c >> 7) * 256 + gate * 128 + (c & 127); }
        default: return n;
    }
}
__device__ __forceinline__ void conv_item(const float* W, int K, int N, bf16* WT, const float* g, int code, LAS float* scr, int item, int lane) {
    const int nblk = N / 32, kb = item / nblk, nb = item % nblk, k0 = 64 * kb, n0 = 32 * nb;
    const int drow0 = map_row(code, n0);
    { float wv[32]; const float* wp = W + (size_t)(k0 + (lane >> 5)) * N + n0 + (lane & 31);
#pragma unroll
      for (int i = 0; i < 32; ++i) wv[i] = wp[(size_t)(2 * i) * N];
#pragma unroll
      for (int i = 0; i < 32; ++i) { const int kk = 2 * i + (lane >> 5); float v = wv[i]; if (g) v *= g[k0 + kk]; scr[kk * 33 + (lane & 31)] = v; } }
    asm volatile("s_waitcnt lgkmcnt(0)" ::: "memory");
    const int c = lane & 7;
#pragma unroll
    for (int j = 0; j < 4; ++j) { const int n = (lane >> 3) + 8 * j; const LAS float* s = scr + (8 * c) * 33 + n;
        v4u o; o.x = cvt_pk_bf16(s[0 * 33], s[1 * 33]); o.y = cvt_pk_bf16(s[2 * 33], s[3 * 33]); o.z = cvt_pk_bf16(s[4 * 33], s[5 * 33]); o.w = cvt_pk_bf16(s[6 * 33], s[7 * 33]);
        *(v4u*)(WT + (size_t)(drow0 + n) * K + k0 + 8 * c) = o; }
    asm volatile("s_waitcnt lgkmcnt(0)" ::: "memory");
}
__device__ __forceinline__ void conv_matrix(const float* W, int K, int N, bf16* WT, const float* g, int code, LAS float* scr, int gw, int NGW, int lane) {
    const int nitems = (K / 64) * (N / 32);
    for (int it = gw; it < nitems; it += NGW) conv_item(W, K, N, WT, g, code, scr, it, lane);
}
__device__ __forceinline__ void row_to_bf16_rstd(const float* xrow, bf16* orow, float* rstd_out, int lane) {
    const f32x4* xr = (const f32x4*)xrow + lane; f32x4 v[8]; float s = 0.f;
#pragma unroll
    for (int j = 0; j < 8; ++j) { v[j] = xr[64 * j]; s += (v[j].x * v[j].x + v[j].y * v[j].y) + (v[j].z * v[j].z + v[j].w * v[j].w); }
    s = wave_sum(s);
    if (lane == 0) *rstd_out = rsqrtf(s * (1.0f / DM) + 1e-6f);
    v2u* o8 = (v2u*)orow + lane;
#pragma unroll
    for (int j = 0; j < 8; ++j) { v2u w; w.x = cvt_pk_bf16(v[j].x, v[j].y); w.y = cvt_pk_bf16(v[j].z, v[j].w); o8[64 * j] = w; }
}

constexpr int LDS_BYTES = 147456;
__global__ void __launch_bounds__(512, 2) fwd_mega(Args args) {
    extern __shared__ __attribute__((aligned(16))) unsigned char lds_raw[];
    LAS unsigned char* lds = (LAS unsigned char*)lds_raw;
    cg::grid_group grid = cg::this_grid();
    const int G = gridDim.x, bid = blockIdx.x;
    const int NGW = G * 8, NGT = G * 512;
#define FRESH() int tid = threadIdx.x; asm volatile("" : "+v"(tid)); const int lane = tid & 63; const int wave = __builtin_amdgcn_readfirstlane(tid >> 6); \
    const int gw = bid * 8 + wave; const int gt = bid * 512 + tid; LAS float* scr = (LAS float*)(lds + wave * 16384); (void)lane; (void)gw; (void)gt; (void)scr
    unsigned char* ws = args.ws;
    const float* x = args.in[0]; const float* attn_norm_g = args.in[1]; const float* w_in = args.in[2]; const float* b_gate = args.in[3];
    const float* q_norm_g = args.in[4]; const float* w_uq = args.in[5]; const float* kv_norm_g = args.in[6]; const float* w_ukv = args.in[7];
    const float* w_o_mla = args.in[8]; const float* w_o_dil = args.in[9]; const float* w_out = args.in[10]; const float* ffn_norm_g = args.in[11];
    const float* w_up = args.in[12]; const float* conv_w = args.in[13]; const float* conv_b = args.in[14]; const float* w_down = args.in[15]; const float* final_norm_g = args.in[16];
    float* out = args.out;
    float* RSTD0 = (float*)(ws + WS_RSTD0); float* SSQQ = (float*)(ws + WS_SSQQ); float* SSQKV = (float*)(ws + WS_SSQKV); float* SSQ1 = (float*)(ws + WS_SSQ1); float* SSQ2 = (float*)(ws + WS_SSQ2);
    float* LSE = (float*)(ws + WS_LSE); f32x2v* ROPE = (f32x2v*)(ws + WS_ROPE);
    bf16* WUQ = (bf16*)(ws + WS_WUQ); bf16* WKV = (bf16*)(ws + WS_WKV); bf16* WOM = (bf16*)(ws + WS_WOM); bf16* WOD = (bf16*)(ws + WS_WOD); bf16* WOUT = (bf16*)(ws + WS_WOUT);
    bf16* WIN = (bf16*)(ws + WS_WIN); bf16* WDN = (bf16*)(ws + WS_WDN); bf16* WUP = (bf16*)(ws + WS_WUP);
    bf16* XB = (bf16*)(ws + WS_A); bf16* OG = (bf16*)(ws + WS_A); bf16* X1B = (bf16*)(ws + WS_A);
    bf16* CQ = (bf16*)(ws + WS_CQ); bf16* CKV = (bf16*)(ws + WS_CKV); float* KPER = (float*)(ws + WS_KPER);
    bf16* DQ = (bf16*)(ws + WS_DQ); bf16* DK = (bf16*)(ws + WS_DK); bf16* DV = (bf16*)(ws + WS_DV);
    bf16* ATT = (bf16*)(ws + WS_ATT); bf16* DIL = (bf16*)(ws + WS_DIL);
    bf16* GA = (bf16*)(ws + WS_GA); bf16* GB = (bf16*)(ws + WS_GB);
    bf16* Q = (bf16*)(ws + WS_Q); bf16* KN = (bf16*)(ws + WS_KN); bf16* KPE = (bf16*)(ws + WS_KPE); bf16* V = (bf16*)(ws + WS_V); bf16* MERGEB = (bf16*)(ws + WS_MERGEB);
    bf16* U = (bf16*)(ws + WS_U); bf16* ACT = (bf16*)(ws + WS_ACT_REAL);
    float* MERGE = out;
    float* X1 = out;

    const int lo = args.ph_lo, hi = args.ph_hi;
#define IN(k) (lo <= (k) && (k) < hi)
#ifndef PROBE_DUP
#define PROBE_DUP 0
#endif
#define NREP(k) (((PROBE_DUP >> (k)) & 1) + 1)
#define REPSYNC() do { if (rep && args.coop) grid.sync(); } while (0)
#define SEAM(k) do { if (IN(k) && IN((k) + 1)) { if (args.coop) grid.sync(); } } while (0)
    float* DUMMY = (float*)(ws + 5 * 65536);

    if (IN(0)) for (int rep = 0; rep < NREP(0); ++rep) { REPSYNC(); FRESH();
        conv_matrix(w_in, DM, 9536, WIN, attn_norm_g, 1, scr, gw, NGW, lane);
        conv_matrix(w_uq, 512, 1536, WUQ, q_norm_g, 0, scr, gw, NGW, lane);
        conv_matrix(w_ukv, 256, 2048, WKV, kv_norm_g, 2, scr, gw, NGW, lane);
        conv_matrix(w_o_mla, 1024, 2048, WOM, nullptr, 0, scr, gw, NGW, lane);
        conv_matrix(w_o_dil, 512, 2048, WOD, nullptr, 0, scr, gw, NGW, lane);
        conv_matrix(w_out, 2048, 2048, WOUT, nullptr, 0, scr, gw, NGW, lane);
        for (int m = gw; m < T; m += NGW) row_to_bf16_rstd(x + (size_t)m * DM, XB + (size_t)m * DM, RSTD0 + m, lane);
        for (int i = gt; i < 4 * T; i += NGT) SSQQ[i] = 0.f;
        for (int i = gt; i < SEQ * 32; i += NGT) { const int pos = i >> 5, f = i & 31; const float inv_freq = powf(10000.0f, -(float)(2 * f) / 64.0f); const float ang = (float)pos * inv_freq;
            float sn, cs; sincosf(ang, &sn, &cs); ROPE[i] = (f32x2v){cs, sn}; }
    }
    SEAM(0);
    if (IN(1)) for (int rep = 0; rep < NREP(1); ++rep) { REPSYNC();
        pg8::Gemm g{XB, WIN, T, N_IN_PAD, DM}; pg8::StaticOrder S; S.init(T, N_IN_PAD, G, bid);
        pg8::EpiProj E{CQ, CKV, DQ, DK, DV, GA, GB, KPER, RSTD0, rep ? nullptr : SSQQ, rep ? nullptr : SSQKV, b_gate};
        pg8::gemm_phase<pg8::EpiProj, pg8::StaticOrder, true, true>(lds, g, S, E);
    }
    SEAM(1);
    if (IN(2)) for (int rep = 0; rep < NREP(2); ++rep) { REPSYNC();
        { pg8::Gemm g{CQ, WUQ, T, 1536, 512}; pg8::StaticOrder S; S.init(T, 1536, G, bid);
          pg8::EpiRowScale E{Q, Q, 1000, 1536, SSQQ, 1.0f / 512.0f};
          pg8::gemm_phase<pg8::EpiRowScale, pg8::StaticOrder, true, true>(lds, g, S, E); }
        { pg8::Gemm g{CKV, WKV, T, 2048, 256}; pg8::StaticOrder S; S.init(T, 2048, G, (bid + 128) % G);
          pg8::EpiRowScale E{KN, V, 4, 1024, SSQKV, 1.0f / 256.0f};
          pg8::gemm_phase<pg8::EpiRowScale, pg8::StaticOrder, true, true>(lds, g, S, E); }
        FRESH();
        for (int i = gt; i < T * 32; i += NGT) { const int t = i >> 5, f = i & 31; const float x1 = KPER[(size_t)t * 64 + f], x2 = KPER[(size_t)t * 64 + 32 + f]; const f32x2v cs = ROPE[(t & (SEQ - 1)) * 32 + f];
            KPE[(size_t)t * 64 + f] = (bf16)(cvt_pk_bf16(x1 * cs.x - x2 * cs.y, 0.f) & 0xffffu); KPE[(size_t)t * 64 + 32 + f] = (bf16)(cvt_pk_bf16(x2 * cs.x + x1 * cs.y, 0.f) & 0xffffu); }
        for (int uid = bid; uid < 768; uid += G) {
            const int g = uid >> 8, rem = uid & 255, b = rem >> 6, hs = (rem >> 4) & 3, sub = rem & 15;
            const int dil = g == 0 ? 1 : (g == 1 ? 4 : 16), nblk = 16 / dil, r = sub / nblk, ublk = sub % nblk;
            const float slope = exp2f(-8.0f * (float)(g * 4 + hs + 1) / 12.0f);
            const size_t rowb = (size_t)b * SEQ + r; const int colb = g * 512 + hs * 128;
#ifndef SKIP_DIL
            attn_unit<128, false>(lds, DQ + rowb * 1536 + colb, (long)dil * 1536, DK + rowb * 1536 + colb, (long)dil * 1536, nullptr, 0, DV + rowb * 1536 + colb, (long)dil * 1536,
                OG + (size_t)g * T * 512 + rowb * 512 + hs * 128, (long)dil * 512, LSE + ((size_t)g * T + rowb) * 4 + hs, (long)dil * 4, ublk * 256, 128,
                0.08838834764831845f * 1.4426950408889634f, slope * (float)dil * 1.4426950408889634f, nullptr);
#endif
        }
    }
    SEAM(2);
    if (IN(3)) for (int rep = 0; rep < NREP(3); ++rep) { REPSYNC();
        for (int it = bid; it < 256; it += G) {
            const int bh = it >> 3, s = it & 7, b = bh >> 3, h = bh & 7;
            const size_t rowb = (size_t)b * SEQ;
#pragma unroll 1
            for (int k = 0; k < 2; ++k) { const int qb = k == 0 ? 15 - s : s;
#ifndef SKIP_MLA
                attn_unit<192, true>(lds, Q + rowb * 1536 + h * 192, 1536, KN + rowb * 1024 + h * 128, 1024, KPE + rowb * 64, 64, V + rowb * 1024 + h * 128, 1024,
                    ATT + rowb * 1024 + h * 128, 1024, nullptr, 0, qb * 256, 1 << 24, 0.07216878364870322f * 1.4426950408889634f, 0.f, ROPE);
#endif
            }
        }
        FRESH();
        for (int i = gt; i < T * 64; i += NGT) {
            const int t = i >> 6, hs = (i >> 4) & 3, c = i & 15;
            const float l0 = LSE[(size_t)t * 4 + hs], l1 = LSE[((size_t)T + t) * 4 + hs], l2 = LSE[((size_t)2 * T + t) * 4 + hs];
            const float mx = fmaxf(l0, fmaxf(l1, l2)); float e0 = __expf(l0 - mx), e1 = __expf(l1 - mx), e2 = __expf(l2 - mx); const float inv = 1.0f / (e0 + e1 + e2); e0 *= inv; e1 *= inv; e2 *= inv;
            const size_t off = (size_t)t * 512 + hs * 128 + c * 8;
            const v4u a = *(const v4u*)(OG + off), b2 = *(const v4u*)(OG + (size_t)T * 512 + off), c2 = *(const v4u*)(OG + (size_t)2 * T * 512 + off); v4u o;
#pragma unroll
            for (int j = 0; j < 4; ++j) o[j] = cvt_pk_bf16(e0 * bflo(a[j]) + e1 * bflo(b2[j]) + e2 * bflo(c2[j]), e0 * bfhi(a[j]) + e1 * bfhi(b2[j]) + e2 * bfhi(c2[j]));
            *(v4u*)(DIL + off) = o;
        }
    }
    SEAM(3);
    if (IN(4)) for (int rep = 0; rep < NREP(4); ++rep) { REPSYNC();
        { FRESH();
        conv_matrix(w_up, DM, NUP, WUP, ffn_norm_g, 3, scr, gw, NGW, lane);
        conv_matrix(w_down, DFF, DM, WDN, nullptr, 0, scr, gw, NGW, lane); }
        __syncthreads();
        { pg8::Gemm g{ATT, WOM, T, DM, 1024}; pg8::StaticOrder S; S.init(T, DM, G, bid);
          pg8::EpiGate E{GA, nullptr, MERGE, nullptr};
          pg8::gemm_phase<pg8::EpiGate, pg8::StaticOrder, true, true>(lds, g, S, E); }
        asm volatile("s_waitcnt vmcnt(0)" ::: "memory"); __syncthreads();
        { pg8::Gemm g{DIL, WOD, T, DM, 512}; pg8::StaticOrder S; S.init(T, DM, G, bid);
          pg8::EpiGate E{GB, MERGE, nullptr, MERGEB};
          pg8::gemm_phase<pg8::EpiGate, pg8::StaticOrder, true, true>(lds, g, S, E); }
    }
    SEAM(4);
    if (IN(5)) for (int rep = 0; rep < NREP(5); ++rep) { REPSYNC();
        pg8::Gemm g{MERGEB, WOUT, T, DM, DM}; pg8::StaticOrder S; S.init(T, DM, G, bid);
        pg8::EpiResid E{x, X1, X1B, rep ? DUMMY : SSQ1};
        pg8::gemm_phase<pg8::EpiResid, pg8::StaticOrder, true, true>(lds, g, S, E);
    }
    SEAM(5);
#pragma unroll 1
    for (int half2 = 0; half2 < 2 * NREP(6); ++half2) { const int half = half2 & 1; if (half2 == 2) { if (args.coop) grid.sync(); }
        const int tile0 = half == 0 ? 0 : UP_TILES_A, ntile = half == 0 ? UP_TILES_A : UP_TILES_B;
        if (IN(6 + 2 * half)) {
            pg8::Gemm g{X1B, WUP + (size_t)tile0 * 256 * DM, T, ntile * 256, DM}; pg8::StaticOrder S; S.init(T, ntile * 256, G, bid);
            pg8::EpiRowScale E{U, U, 1000, ntile * 256, SSQ1, 1.0f / 2048.0f};
            pg8::gemm_phase<pg8::EpiRowScale, pg8::StaticOrder, true, true>(lds, g, S, E);
        }
        SEAM(6 + 2 * half);
        if (IN(7 + 2 * half)) {
            FRESH();
            const int ldu = ntile * 256; const int nitems = (T / 16) * ntile * 16;
            for (int it = gt; it < nitems; it += NGT) {
                const int ch = it & 15, tl = (it >> 4) % ntile, rb = (it >> 4) / ntile; const int t0 = rb * 16;
                const int cu = (tile0 + tl) * 128 + ch * 8, cg_ = DFF + cu;
                float wu[3][8], wg[3][8], bu[8], bg[8];
#pragma unroll
                for (int k = 0; k < 3; ++k)
#pragma unroll
                    for (int j = 0; j < 8; ++j) { wu[k][j] = conv_w[(size_t)k * NUP + cu + j]; wg[k][j] = conv_w[(size_t)k * NUP + cg_ + j]; }
#pragma unroll
                for (int j = 0; j < 8; ++j) { bu[j] = conv_b[cu + j]; bg[j] = conv_b[cg_ + j]; }
                const bf16* up_ = U + (size_t)t0 * ldu + tl * 256 + ch * 8;
                v4u u2 = (v4u){0u, 0u, 0u, 0u}, u1 = u2, g2 = u2, g1 = u2;
                if ((t0 & (SEQ - 1)) != 0) { u2 = *(const v4u*)(up_ - 2 * (size_t)ldu); u1 = *(const v4u*)(up_ - (size_t)ldu); g2 = *(const v4u*)(up_ - 2 * (size_t)ldu + 128); g1 = *(const v4u*)(up_ - (size_t)ldu + 128); }
#pragma unroll 4
                for (int rr = 0; rr < 16; ++rr) {
                    const v4u u0 = *(const v4u*)(up_ + (size_t)rr * ldu), g0 = *(const v4u*)(up_ + (size_t)rr * ldu + 128); v4u o;
#pragma unroll
                    for (int j = 0; j < 4; ++j) {
                        const float ua = bu[2 * j] + wu[0][2 * j] * bflo(u2[j]) + wu[1][2 * j] * bflo(u1[j]) + wu[2][2 * j] * bflo(u0[j]);
                        const float ub = bu[2 * j + 1] + wu[0][2 * j + 1] * bfhi(u2[j]) + wu[1][2 * j + 1] * bfhi(u1[j]) + wu[2][2 * j + 1] * bfhi(u0[j]);
                        const float ga = bg[2 * j] + wg[0][2 * j] * bflo(g2[j]) + wg[1][2 * j] * bflo(g1[j]) + wg[2][2 * j] * bflo(g0[j]);
                        const float gb = bg[2 * j + 1] + wg[0][2 * j + 1] * bfhi(g2[j]) + wg[1][2 * j + 1] * bfhi(g1[j]) + wg[2][2 * j + 1] * bfhi(g0[j]);
                        o[j] = cvt_pk_bf16(ua * ga / (1.0f + __expf(-ga)), ub * gb / (1.0f + __expf(-gb)));
                    }
                    *(v4u*)(ACT + (size_t)(t0 + rr) * DFF + cu) = o;
                    u2 = u1; u1 = u0; g2 = g1; g1 = g0;
                }
            }
        }
        SEAM(7 + 2 * half);
    }
    if (IN(10)) for (int rep = 0; rep < NREP(10); ++rep) { REPSYNC();
        pg8::Gemm g{ACT, WDN, T, DM, DFF}; pg8::StaticOrder S; S.init(T, DM, G, bid);
        pg8::EpiResid E{X1, rep ? (float*)U : X1, nullptr, rep ? DUMMY : SSQ2};
        pg8::gemm_phase<pg8::EpiResid, pg8::StaticOrder, true, true>(lds, g, S, E);
    }
    SEAM(10);
    if (IN(11)) { FRESH();
        for (int m = gw; m < T; m += NGW) {
            const float rs = rsqrtf(SSQ2[m] * (1.0f / DM) + 1e-6f);
            f32x4* xr = (f32x4*)(out + (size_t)m * DM) + lane; const f32x4* gr = (const f32x4*)final_norm_g + lane;
#pragma unroll
            for (int j = 0; j < 8; ++j) { const f32x4 v = xr[64 * j]; const f32x4 gg = gr[64 * j]; xr[64 * j] = v * rs * gg; }
        }
    }
#undef IN
#undef SEAM
}

#ifndef MK_N_LAUNCHES
#define MK_N_LAUNCHES 1
#endif
extern "C" void kernel_launch(void* const* d_in, const int* in_sizes, int n_in, void* d_out, int out_size, void* d_ws, size_t ws_size, hipStream_t stream) {
    static int grid = 0;
    if (grid == 0) {
        int dev = 0, cus = 0, per_cu = 0;
        if (n_in != 17 || out_size != T * DM || ws_size < WS_END) { fprintf(stderr, "kernel_launch: unexpected shapes / workspace (%d inputs, out %d, ws %zu)\n", n_in, out_size, ws_size); grid = -1; return; }
        (void)hipGetDevice(&dev);
        (void)hipDeviceGetAttribute(&cus, hipDeviceAttributeMultiprocessorCount, dev);
        (void)hipFuncSetAttribute((const void*)fwd_mega, hipFuncAttributeMaxDynamicSharedMemorySize, LDS_BYTES);
        (void)hipOccupancyMaxActiveBlocksPerMultiprocessor(&per_cu, (const void*)fwd_mega, 512, LDS_BYTES);
        if (per_cu < 1) per_cu = 1;
        grid = cus * per_cu;
        if (grid % 8 != 0 || grid < 8) grid = -1;
    }
    if (grid < 0) return;
    Args a{};
    for (int i = 0; i < 17; ++i) a.in[i] = (const float*)d_in[i];
    a.out = (float*)d_out; a.ws = (unsigned char*)d_ws;
#if MK_N_LAUNCHES == 1
    a.ph_lo = 0; a.ph_hi = 12; a.coop = 1;
    void* kargs[] = {&a};
    hipError_t e = hipLaunchCooperativeKernel((const void*)fwd_mega, dim3(grid), dim3(512), kargs, LDS_BYTES, stream);
    if (e != hipSuccess) fprintf(stderr, "cooperative launch failed: %s (grid %d)\n", hipGetErrorString(e), grid);
#else
    for (int p = 0; p < 12; ++p) { a.ph_lo = p; a.ph_hi = p + 1; a.coop = 0; hipLaunchKernelGGL(fwd_mega, dim3(grid), dim3(512), LDS_BYTES, stream, a); }
#endif
}
```

```cpp
#include <hip/hip_runtime.h>
#include <hip/hip_cooperative_groups.h>
#include <cstdio>
#include <cstdint>
namespace cg = cooperative_groups;
namespace pg8 {
#define PG8_LAS __attribute__((address_space(3)))
typedef unsigned short bf16_t;
typedef short bf16x8 __attribute__((ext_vector_type(8)));
typedef float f32x4 __attribute__((ext_vector_type(4)));
typedef unsigned u32x4 __attribute__((ext_vector_type(4)));
constexpr int BM = 256, BK = 64, HALF = 128, HTB = HALF * BK * 2  , STAGE_BYTES = 8 * HTB, NXCD = 8, WGM = 8;

__host__ __device__ __forceinline__ int lds_byte(int r, int c) { const int st = (r >> 4) * 2 + (c >> 5), rr = r & 15, cc = c & 31, ob = rr * 64 + cc * 2; return st * 1024 + (ob ^ (((ob >> 9) & 1) << 5)); }
__host__ __device__ __forceinline__ void stage_rc(int b, int& R, int& C) { const int st = b / 1024, sb = b % 1024, swz = sb ^ (((sb >> 9) & 1) << 5); R = (st >> 1) * 16 + swz / 64; C = (st & 1) * 32 + (swz % 64) / 2; }
__host__ __device__ __forceinline__ int perm32(int rho) { const int n = rho >> 4, i = rho & 15; return 8 * (i >> 2) + 4 * n + (i & 3); }

struct Unit { int pm, pn; };
struct Gemm { const bf16_t* A; const bf16_t* Bt; int M, N, K; };

struct StaticOrder {
    int nM, nN, nwg, G, c;
    __host__ __device__ void init(int M, int N, int G_, int c_) { nM = M / BM; nN = N / BM; nwg = nM * nN; G = G_; c = c_; }
    __host__ __device__ bool next(int i, Unit& u) const {
        const long L = (long)i * G + c; if (L >= nwg) return false;
        int wgid = (int)L; { const int q = nwg / NXCD, r = nwg % NXCD, xcd = wgid % NXCD, off = wgid / NXCD; wgid = (xcd < r ? xcd * (q + 1) : r * (q + 1) + (xcd - r) * q) + off; }
        const int nig = WGM * nN, gid = wgid / nig, fm = gid * WGM, gsz = (nM - fm) < WGM ? (nM - fm) : WGM;
        u.pm = fm + ((wgid % nig) % gsz); u.pn = (wgid % nig) / gsz; return true;
    }
    __device__ __forceinline__ void a_ready(const Unit&) const {}
    __device__ __forceinline__ void done(const Unit&) const {}
};

__device__ __forceinline__ unsigned cvt_pk_bf16(float lo, float hi) { unsigned r; asm volatile("v_cvt_pk_bf16_f32 %0, %1, %2" : "=v"(r) : "v"(lo), "v"(hi)); return r; }
typedef float f32x2 __attribute__((ext_vector_type(2)));
typedef unsigned u32x2 __attribute__((ext_vector_type(2)));
constexpr float NORM_EPS_F = 1e-6f;
__device__ __forceinline__ float bf_lo(unsigned w) { return __uint_as_float(w << 16); }
__device__ __forceinline__ float bf_hi(unsigned w) { return __uint_as_float(w & 0xffff0000u); }
__device__ __forceinline__ u32x4 pack8(const f32x4 a, const f32x4 b) { u32x4 w; w.x = cvt_pk_bf16(a[0], a[1]); w.y = cvt_pk_bf16(a[2], a[3]); w.z = cvt_pk_bf16(b[0], b[1]); w.w = cvt_pk_bf16(b[2], b[3]); return w; }
__device__ __forceinline__ float sq8(const f32x4 a, const f32x4 b) { return (a[0] * a[0] + a[1] * a[1]) + (a[2] * a[2] + a[3] * a[3]) + (b[0] * b[0] + b[1] * b[1]) + (b[2] * b[2] + b[3] * b[3]); }
__device__ __forceinline__ float sigm(float v) { return __builtin_amdgcn_rcpf(1.0f + __expf(-v)); }

struct EpiProj {
    static constexpr bool PERM = true, AFTER_DRAIN = false, HAS_MIDK = false;
    bf16_t *CQ, *CKV, *DQ, *DK, *DV, *GA, *GB; float* KPER; const float* rstd0; float *ssq_q, *ssq_kv; const float* b_gate;
    __device__ __forceinline__ void operator()(const f32x4 (&acc)[2][2][4][2], const Unit& u, int wr, int wc, int fr, int fq) const {
        const int pn = u.pn; const int row0 = u.pm * BM + wr * 64 + fr; const int cw = wc * 32 + 8 * fq;
        bf16_t* base = CQ; int ldc = 512, c0 = 0; const float* bias = nullptr; float* ssq = nullptr;
        if (pn < 2) { base = CQ; ldc = 512; c0 = pn * 256; ssq = ssq_q; }
        else if (pn == 2) { base = CKV; ldc = 256; c0 = 0; ssq = ssq_kv; }
        else if (pn == 3) { base = nullptr; }
        else if (pn < 10) { base = DQ; ldc = 1536; c0 = (pn - 4) * 256; }
        else if (pn < 16) { base = DK; ldc = 1536; c0 = (pn - 10) * 256; }
        else if (pn < 22) { base = DV; ldc = 1536; c0 = (pn - 16) * 256; }
        else if (pn < 30) { base = GA; ldc = 2048; c0 = (pn - 22) * 256; bias = b_gate + c0; }
        else { base = GB; ldc = 2048; c0 = (pn - 30) * 256; bias = b_gate + 2048 + c0; }
        if (base == nullptr) {
            if (wc < 2) {
#pragma unroll
                for (int ai = 0; ai < 2; ++ai)
#pragma unroll
                    for (int m = 0; m < 4; ++m) { const int row = row0 + ai * HALF + m * 16; const float rs = rstd0[row];
                        float* p = KPER + (size_t)row * 64 + cw; *(f32x4*)p = acc[ai][0][m][0] * rs; *(f32x4*)(p + 4) = acc[ai][0][m][1] * rs; }
            }
            return;
        }
        f32x4 bv[2][2];
#pragma unroll
        for (int bj = 0; bj < 2; ++bj)
#pragma unroll
            for (int n = 0; n < 2; ++n) bv[bj][n] = bias ? *(const f32x4*)(bias + bj * HALF + cw + 4 * n) : (f32x4){0.f, 0.f, 0.f, 0.f};
#pragma unroll
        for (int ai = 0; ai < 2; ++ai)
#pragma unroll
            for (int m = 0; m < 4; ++m) { const int row = row0 + ai * HALF + m * 16; const float rs = rstd0[row]; bf16_t* rowp = base + (size_t)row * ldc + c0 + cw; float s = 0.f;
#pragma unroll
                for (int bj = 0; bj < 2; ++bj) { f32x4 v0 = acc[ai][bj][m][0] * rs, v1 = acc[ai][bj][m][1] * rs;
                    if (bias) { v0 = v0 + bv[bj][0]; v1 = v1 + bv[bj][1];
#pragma unroll
                        for (int e = 0; e < 4; ++e) { v0[e] = sigm(v0[e]); v1[e] = sigm(v1[e]); } }
                    s += sq8(v0, v1);
                    *(u32x4*)(rowp + bj * HALF) = pack8(v0, v1); }
                if (ssq) { s += __shfl_xor(s, 16); s += __shfl_xor(s, 32); if (fq == 0) atomicAdd(ssq + row, s); } }
    }
};

struct EpiRowScale {
    static constexpr bool PERM = true, AFTER_DRAIN = false, HAS_MIDK = false;
    bf16_t *O0, *O1; int split, ldc; const float* ssq; float inv_dim;
    __device__ __forceinline__ void operator()(const f32x4 (&acc)[2][2][4][2], const Unit& u, int wr, int wc, int fr, int fq) const {
        const int pn = u.pn; const int row0 = u.pm * BM + wr * 64 + fr; const int cw = wc * 32 + 8 * fq;
        bf16_t* base = pn < split ? O0 : O1; const int c0 = (pn < split ? pn : pn - split) * 256;
#pragma unroll
        for (int ai = 0; ai < 2; ++ai)
#pragma unroll
            for (int m = 0; m < 4; ++m) { const int row = row0 + ai * HALF + m * 16; const float rs = rsqrtf(ssq[row] * inv_dim + NORM_EPS_F); bf16_t* rowp = base + (size_t)row * ldc + c0 + cw;
#pragma unroll
                for (int bj = 0; bj < 2; ++bj) *(u32x4*)(rowp + bj * HALF) = pack8(acc[ai][bj][m][0] * rs, acc[ai][bj][m][1] * rs); }
    }
};

struct EpiGate {
    static constexpr bool PERM = true, AFTER_DRAIN = false, HAS_MIDK = false;
    const bf16_t* G; const float* addin; float* outf; bf16_t* outb;
    __device__ __forceinline__ void operator()(const f32x4 (&acc)[2][2][4][2], const Unit& u, int wr, int wc, int fr, int fq) const {
        const int row0 = u.pm * BM + wr * 64 + fr; const int col0 = u.pn * BM + wc * 32 + 8 * fq;
#pragma unroll
        for (int ai = 0; ai < 2; ++ai)
#pragma unroll
            for (int m = 0; m < 4; ++m) { const size_t off = (size_t)(row0 + ai * HALF + m * 16) * 2048 + col0;
#pragma unroll
                for (int bj = 0; bj < 2; ++bj) { const u32x4 g = *(const u32x4*)(G + off + bj * HALF);
                    f32x4 v0 = acc[ai][bj][m][0] * (f32x4){bf_lo(g.x), bf_hi(g.x), bf_lo(g.y), bf_hi(g.y)};
                    f32x4 v1 = acc[ai][bj][m][1] * (f32x4){bf_lo(g.z), bf_hi(g.z), bf_lo(g.w), bf_hi(g.w)};
                    if (addin) { v0 = v0 + *(const f32x4*)(addin + off + bj * HALF); v1 = v1 + *(const f32x4*)(addin + off + bj * HALF + 4); }
                    if (outf) { *(f32x4*)(outf + off + bj * HALF) = v0; *(f32x4*)(outf + off + bj * HALF + 4) = v1; }
                    if (outb) *(u32x4*)(outb + off + bj * HALF) = pack8(v0, v1); } }
    }
};

struct EpiResid {
    static constexpr bool PERM = true, AFTER_DRAIN = false, HAS_MIDK = false;
    const float* resid; float* outf; bf16_t* outb; float* ssq;
    __device__ __forceinline__ void operator()(const f32x4 (&acc)[2][2][4][2], const Unit& u, int wr, int wc, int fr, int fq) const {
        const int row0 = u.pm * BM + wr * 64 + fr; const int col0 = u.pn * BM + wc * 32 + 8 * fq;
#ifndef EPI_REP
#define EPI_REP 1
#endif
#pragma unroll 1
        for (int rp = 0; rp < 1; ++rp)
#pragma unroll
        for (int ai = 0; ai < 2; ++ai)
#pragma unroll
            for (int m = 0; m < 4; ++m) { const int row = row0 + ai * HALF + m * 16; const size_t off = (size_t)row * 2048 + col0; float s = 0.f;
#pragma unroll
                for (int bj = 0; bj < 2; ++bj) { const f32x4 v0 = acc[ai][bj][m][0] + *(const f32x4*)(resid + off + bj * HALF), v1 = acc[ai][bj][m][1] + *(const f32x4*)(resid + off + bj * HALF + 4);
                    s += sq8(v0, v1);
                    *(f32x4*)(outf + off + bj * HALF) = v0; *(f32x4*)(outf + off + bj * HALF + 4) = v1;
                    if (outb) *(u32x4*)(outb + off + bj * HALF) = pack8(v0, v1); }
                s += __shfl_xor(s, 16); s += __shfl_xor(s, 32); if (fq == 0 && rp == 0) atomicAdd(ssq + row, s); asm volatile("" ::: "memory"); }
    }
};


#define PG8_DPPV(NAME, CTRLSTR) __device__ __forceinline__ f32x4 NAME(f32x4 oldv, const f32x4 v) { \
    _Pragma("unroll") for (int e = 0; e < 4; ++e) { float o = oldv[e]; const float s_ = v[e]; \
        asm volatile("s_nop 1\n\tv_mov_b32_dpp %0, %1 " CTRLSTR " row_mask:0xf bank_mask:0xf" : "+v"(o) : "v"(s_)); oldv[e] = o; } \
    return oldv; }
PG8_DPPV(dpp_shr1, "row_shr:1")
PG8_DPPV(dpp_shr2, "row_shr:2")
PG8_DPPV(dpp_shl15, "row_shl:15")
PG8_DPPV(dpp_shl14, "row_shl:14")
__device__ __forceinline__ f32x4 prev1(const f32x4 xp, const f32x4 x) { const f32x4 z = (f32x4){0.f, 0.f, 0.f, 0.f}; return dpp_shr1(dpp_shl15(z, xp), x); }
__device__ __forceinline__ f32x4 prev2(const f32x4 xp, const f32x4 x) { const f32x4 z = (f32x4){0.f, 0.f, 0.f, 0.f}; return dpp_shr2(dpp_shl14(z, xp), x); }
struct EpiConvAct {
    static constexpr bool PERM = true, AFTER_DRAIN = false, HAS_MIDK = false;
    bf16_t* ACT; const float* ssq; const float* conv_w; const float* conv_b; float* HEAD; float* TAIL; PG8_LAS unsigned char* xch;
    static __device__ __forceinline__ int slot(int ai, int wr, int wc, int rr, int fq) { return ((((ai * 2 + wr) * 4 + wc) * 2 + rr) * 4 + fq) * 4; }
    __device__ __forceinline__ void operator()(const f32x4 (&acc)[2][2][4][2], const Unit& u, int wr, int wc, int fr, int fq) const {
        PG8_LAS f32x4* X = (PG8_LAS f32x4*)xch;
        const int row0 = u.pm * BM + wr * 64 + fr; const int cw = wc * 32 + 8 * fq; const int colt = u.pn * 256;
        float rs[2][4];
#pragma unroll
        for (int ai = 0; ai < 2; ++ai)
#pragma unroll
            for (int m = 0; m < 4; ++m) rs[ai][m] = rsqrtf(ssq[row0 + ai * HALF + m * 16] * (1.0f / 2048.0f) + NORM_EPS_F);
        if (fr >= 14) {
#pragma unroll
            for (int ai = 0; ai < 2; ++ai) { const int b = slot(ai, wr, wc, fr - 14, fq);
#pragma unroll
                for (int bj = 0; bj < 2; ++bj)
#pragma unroll
                    for (int n = 0; n < 2; ++n) { const f32x4 v = acc[ai][bj][3][n] * rs[ai][3]; X[b + bj * 2 + n] = v;
                        if (ai == 1 && wr == 1) *(f32x4*)(TAIL + (size_t)(u.pm * 2 + (fr - 14)) * 11008 + colt + bj * HALF + cw + 4 * n) = v; } }
        }
        if (fr < 2 && wr == 0) {
#pragma unroll
            for (int bj = 0; bj < 2; ++bj)
#pragma unroll
                for (int n = 0; n < 2; ++n) *(f32x4*)(HEAD + (size_t)(u.pm * 2 + fr) * 11008 + colt + bj * HALF + cw + 4 * n) = acc[0][bj][0][n] * rs[0][0];
        }
        asm volatile("s_waitcnt lgkmcnt(0)" ::: "memory"); __builtin_amdgcn_s_barrier(); asm volatile("" ::: "memory");
#pragma unroll
        for (int n = 0; n < 2; ++n) {
            const int c = u.pn * 128 + cw + 4 * n;
            f32x4 wu[3], wg[3];
#pragma unroll
            for (int k = 0; k < 3; ++k) { wu[k] = *(const f32x4*)(conv_w + (size_t)k * 11008 + c); wg[k] = *(const f32x4*)(conv_w + (size_t)k * 11008 + 5504 + c); }
            const f32x4 bu = *(const f32x4*)(conv_b + c), bg = *(const f32x4*)(conv_b + 5504 + c);
#pragma unroll
            for (int ai = 0; ai < 2; ++ai) {
                f32x4 pu = (f32x4){0.f, 0.f, 0.f, 0.f}, pg = pu;
                if (!(ai == 0 && wr == 0)) { const int b = slot(wr == 1 ? ai : ai - 1, wr ^ 1, wc, fr & 1, fq); pu = X[b + n]; pg = X[b + 2 + n]; }
#pragma unroll
                for (int m = 0; m < 4; ++m) {
                    const f32x4 xu = acc[ai][0][m][n] * rs[ai][m], xg = acc[ai][1][m][n] * rs[ai][m];
                    const f32x4 p1u = prev1(pu, xu), p2u = prev2(pu, xu), p1g = prev1(pg, xg), p2g = prev2(pg, xg);
                    const f32x4 cu = bu + wu[0] * p2u + wu[1] * p1u + wu[2] * xu, cgt = bg + wg[0] * p2g + wg[1] * p1g + wg[2] * xg;
                    float a[4];
#pragma unroll
                    for (int e = 0; e < 4; ++e) a[e] = cu[e] * cgt[e] * __builtin_amdgcn_rcpf(1.0f + __expf(-cgt[e]));
                    u32x2 w; w.x = cvt_pk_bf16(a[0], a[1]); w.y = cvt_pk_bf16(a[2], a[3]);
                    *(u32x2*)(ACT + (size_t)(row0 + ai * HALF + m * 16) * 5504 + c) = w;
                    pu = xu; pg = xg;
                }
            }
        }
    }
};

struct EpiMerge {
    static constexpr bool PERM = true, AFTER_DRAIN = false, HAS_MIDK = true;
    const bf16_t* GA; const bf16_t* GB; bf16_t* outb; int midk_t;
    __device__ __forceinline__ void midk(f32x4 (&acc)[2][2][4][2], const Unit& u, int wr, int wc, int fr, int fq) const {
        int row0 = u.pm * BM + wr * 64 + fr; const int col0 = u.pn * BM + wc * 32 + 8 * fq;
        asm volatile("" : "+v"(row0));
#pragma unroll
        for (int ai = 0; ai < 2; ++ai)
#pragma unroll
            for (int m = 0; m < 4; ++m) { const unsigned off = (unsigned)((row0 + ai * HALF + m * 16) * 2048 + col0);
#pragma unroll
                for (int bj = 0; bj < 2; ++bj) { const u32x4 a = *(const u32x4*)(GA + off + bj * HALF), b = *(const u32x4*)(GB + off + bj * HALF);
                    f32x4 r0, r1;
                    r0[0] = bf_lo(a.x) * __builtin_amdgcn_rcpf(fmaxf(bf_lo(b.x), 1e-20f)); r0[1] = bf_hi(a.x) * __builtin_amdgcn_rcpf(fmaxf(bf_hi(b.x), 1e-20f)); r0[2] = bf_lo(a.y) * __builtin_amdgcn_rcpf(fmaxf(bf_lo(b.y), 1e-20f)); r0[3] = bf_hi(a.y) * __builtin_amdgcn_rcpf(fmaxf(bf_hi(b.y), 1e-20f));
                    r1[0] = bf_lo(a.z) * __builtin_amdgcn_rcpf(fmaxf(bf_lo(b.z), 1e-20f)); r1[1] = bf_hi(a.z) * __builtin_amdgcn_rcpf(fmaxf(bf_hi(b.z), 1e-20f)); r1[2] = bf_lo(a.w) * __builtin_amdgcn_rcpf(fmaxf(bf_lo(b.w), 1e-20f)); r1[3] = bf_hi(a.w) * __builtin_amdgcn_rcpf(fmaxf(bf_hi(b.w), 1e-20f));
                    acc[ai][bj][m][0] = acc[ai][bj][m][0] * r0; acc[ai][bj][m][1] = acc[ai][bj][m][1] * r1; } }
    }
    __device__ __forceinline__ void operator()(const f32x4 (&acc)[2][2][4][2], const Unit& u, int wr, int wc, int fr, int fq) const {
        const int row0 = u.pm * BM + wr * 64 + fr; const int col0 = u.pn * BM + wc * 32 + 8 * fq;
#pragma unroll
        for (int ai = 0; ai < 2; ++ai)
#pragma unroll
            for (int m = 0; m < 4; ++m) { const size_t off = (size_t)(row0 + ai * HALF + m * 16) * 2048 + col0;
#pragma unroll
                for (int bj = 0; bj < 2; ++bj) { const u32x4 b = *(const u32x4*)(GB + off + bj * HALF);
                    const f32x4 g0 = (f32x4){fmaxf(bf_lo(b.x), 1e-20f), fmaxf(bf_hi(b.x), 1e-20f), fmaxf(bf_lo(b.y), 1e-20f), fmaxf(bf_hi(b.y), 1e-20f)};
                    const f32x4 g1 = (f32x4){fmaxf(bf_lo(b.z), 1e-20f), fmaxf(bf_hi(b.z), 1e-20f), fmaxf(bf_lo(b.w), 1e-20f), fmaxf(bf_hi(b.w), 1e-20f)};
                    *(u32x4*)(outb + off + bj * HALF) = pack8(acc[ai][bj][m][0] * g0, acc[ai][bj][m][1] * g1); } }
    }
};

struct EpiColScale {
    static constexpr bool PERM = true, AFTER_DRAIN = false, HAS_MIDK = false;
    bf16_t* O; int ldc; const float* ssq; float inv_dim;
    __device__ __forceinline__ void operator()(const f32x4 (&acc)[2][2][4][2], const Unit& u, int wr, int wc, int fr, int fq) const {
        int row0 = u.pm * BM + wr * 64 + fr; const int col0 = u.pn * BM + wc * 32 + 8 * fq;
        asm volatile("" : "+v"(row0));
#pragma unroll
        for (int bj = 0; bj < 2; ++bj)
#pragma unroll
            for (int n = 0; n < 2; ++n) {
                f32x4 c = *(const f32x4*)(ssq + col0 + bj * HALF + 4 * n);
#pragma unroll
                for (int e = 0; e < 4; ++e) c[e] = rsqrtf(c[e] * inv_dim + NORM_EPS_F);
#pragma unroll
                for (int ai = 0; ai < 2; ++ai)
#pragma unroll
                    for (int m = 0; m < 4; ++m) { const f32x4 v = acc[ai][bj][m][n] * c; u32x2 w; w.x = cvt_pk_bf16(v[0], v[1]); w.y = cvt_pk_bf16(v[2], v[3]);
                        *(u32x2*)(O + (size_t)(row0 + ai * HALF + m * 16) * ldc + col0 + bj * HALF + 4 * n) = w; }
            }
    }
};

struct RangeOrder {
    StaticOrder S; int i0, n;
    __host__ __device__ bool next(int i, Unit& u) const { return i < n && S.next(i0 + i, u); }
    __device__ __forceinline__ void a_ready(const Unit&) const {}
    __device__ __forceinline__ void done(const Unit&) const {}
};
template <class Epi, class Sched, bool ALIGN_EPI = false, bool SP2 = false>
__device__ __forceinline__ void gemm_phase(PG8_LAS unsigned char* lds, const Gemm g, const Sched& S, const Epi& E, const int tid_in) {
    int tid_ = tid_in; asm volatile("" : "+v"(tid_));
    const int tid = tid_, wid = __builtin_amdgcn_readfirstlane(tid >> 6), lane = tid & 63, wr = wid >> 2, wc = wid & 3, fr = lane & 15, fq = lane >> 4;
    const int K = g.K, nt = K / BK;
    unsigned voffA[2], voffB[2];
#pragma unroll
    for (int i = 0; i < 2; ++i) { int R, C; stage_rc(tid * 16 + i * 8192, R, C); const int Rb = Epi::PERM ? ((R & ~31) + perm32(R & 31)) : R;
        voffA[i] = (unsigned)(R * K + C) * 2u; voffB[i] = (unsigned)(Rb * K + C) * 2u; }
    const size_t kstep = (size_t)(BK * 2);
    const size_t hstep = (size_t)HALF * K * 2;
    const size_t tstep = 2 * hstep;
    const unsigned ldsw = (unsigned)wid * 1024u;
    const int aoff = lds_byte(wr * 64 + fr, fq * 8), boff = lds_byte(wc * 32 + fr, fq * 8);
#define PG8_SA(b, h) (((b) * 2 + (h)) * HTB)
#define PG8_SB(b, h) ((4 + (b) * 2 + (h)) * HTB)
#define PG8_STAGE(bufoff, gbase, voff) do { _Pragma("unroll") for (int _i = 0; _i < 2; ++_i) \
        __builtin_amdgcn_global_load_lds((const unsigned*)((const char*)(gbase) + (voff)[_i]), (PG8_LAS unsigned*)(lds + (bufoff) + ldsw + _i * 8192), 16, 0, 0); } while (0)
#define PG8_LDA(dst, b, h) do { _Pragma("unroll") for (int m = 0; m < 4; ++m) _Pragma("unroll") for (int k = 0; k < 2; ++k) dst[m][k] = *(const PG8_LAS bf16x8*)(lds + PG8_SA(b, h) + aoff + m * 2048 + k * 1024); } while (0)
#define PG8_LDB(dst, b, h) do { _Pragma("unroll") for (int n = 0; n < 2; ++n) _Pragma("unroll") for (int k = 0; k < 2; ++k) dst[n][k] = *(const PG8_LAS bf16x8*)(lds + PG8_SB(b, h) + boff + n * 2048 + k * 1024); } while (0)
#define PG8_MMA(ai, bj, At, Bt) do { __builtin_amdgcn_s_setprio(1); _Pragma("unroll") for (int m = 0; m < 4; ++m) _Pragma("unroll") for (int n = 0; n < 2; ++n) _Pragma("unroll") for (int k = 0; k < 2; ++k) \
        acc[ai][bj][m][n] = __builtin_amdgcn_mfma_f32_16x16x32_bf16(Bt[n][k], At[m][k], acc[ai][bj][m][n], 0, 0, 0); __builtin_amdgcn_s_setprio(0); } while (0)
#define PG8_WAIT_V(n) asm volatile("s_waitcnt vmcnt(" #n ")" ::: "memory")
#define PG8_WAIT_L(n) asm volatile("s_waitcnt lgkmcnt(" #n ")" ::: "memory")
#define PG8_BAR __builtin_amdgcn_s_barrier()
#define PG8_SCHED __builtin_amdgcn_sched_barrier(0)
    Unit cur, nxt; int ui = 0;
    if (!S.next(0, cur)) return;
    f32x4 acc[2][2][4][2];
#pragma unroll
    for (int a = 0; a < 2; ++a)
#pragma unroll
        for (int b = 0; b < 2; ++b)
#pragma unroll
            for (int m = 0; m < 4; ++m)
#pragma unroll
                for (int n = 0; n < 2; ++n) acc[a][b][m][n] = (f32x4){0.f, 0.f, 0.f, 0.f};
    bf16x8 At[4][2], B0[2][2], B1[2][2];
    const char* cA = (const char*)g.A + (size_t)cur.pm * tstep; const char* cB = (const char*)g.Bt + (size_t)cur.pn * tstep;
    S.a_ready(cur);
    if constexpr (SP2) {
        PG8_STAGE(PG8_SB(0, 0), cB, voffB); PG8_STAGE(PG8_SB(0, 1), cB + hstep, voffB); PG8_STAGE(PG8_SA(0, 0), cA, voffA); PG8_STAGE(PG8_SA(0, 1), cA + hstep, voffA);
        if (wr == 1) PG8_BAR;
        PG8_WAIT_V(2); PG8_BAR;
        PG8_STAGE(PG8_SB(1, 0), cB + kstep, voffB); PG8_STAGE(PG8_SA(1, 0), cA + kstep, voffA); PG8_STAGE(PG8_SB(1, 1), cB + hstep + kstep, voffB);
        PG8_WAIT_V(6); PG8_BAR;
    } else {
        PG8_STAGE(PG8_SB(0, 0), cB, voffB); PG8_STAGE(PG8_SA(0, 0), cA, voffA); PG8_STAGE(PG8_SB(0, 1), cB + hstep, voffB); PG8_STAGE(PG8_SA(0, 1), cA + hstep, voffA);
        if (wr == 1) PG8_BAR;
        PG8_WAIT_V(4); PG8_BAR;
        PG8_STAGE(PG8_SB(1, 0), cB + kstep, voffB); PG8_STAGE(PG8_SA(1, 0), cA + kstep, voffA); PG8_STAGE(PG8_SB(1, 1), cB + hstep + kstep, voffB);
        PG8_WAIT_V(6); PG8_BAR;
    }
    for (;;) {
        const bool has_next = S.next(ui + 1, nxt);
        const char* nA = has_next ? (const char*)g.A + (size_t)nxt.pm * tstep : cA; const char* nB = has_next ? (const char*)g.Bt + (size_t)nxt.pn * tstep : cB;
        for (int t = 0; t < nt; t += 2) {
            if constexpr (Epi::HAS_MIDK) { if (t == E.midk_t) E.midk(acc, cur, wr, wc, fr, fq); }
            const bool last = (t == nt - 2);
            const char* a1 = cA + (size_t)(t + 1) * kstep;
            const char* a2 = last ? nA : cA + (size_t)(t + 2) * kstep; const char* b2 = last ? nB : cB + (size_t)(t + 2) * kstep;
            const char* a3 = a2 + kstep; const char* b3 = b2 + kstep;
            if (last && has_next) S.a_ready(nxt);
            if constexpr (SP2) {
            PG8_LDB(B0, 0, 0); PG8_LDB(B1, 0, 1); PG8_SCHED; PG8_LDA(At, 0, 0); PG8_STAGE(PG8_SA(1, 1), a1 + hstep, voffA);
            PG8_WAIT_V(8); PG8_WAIT_L(0); PG8_BAR; PG8_MMA(0, 0, At, B0); PG8_MMA(0, 1, At, B1); PG8_BAR; PG8_SCHED;
            PG8_LDA(At, 0, 1); PG8_STAGE(PG8_SB(0, 0), b2, voffB); PG8_STAGE(PG8_SB(0, 1), b2 + hstep, voffB); PG8_STAGE(PG8_SA(0, 0), a2, voffA);
            PG8_WAIT_V(8); PG8_WAIT_L(0); PG8_BAR; PG8_MMA(1, 0, At, B0); PG8_MMA(1, 1, At, B1); PG8_BAR; PG8_SCHED;
            PG8_LDB(B0, 1, 0); PG8_LDB(B1, 1, 1); PG8_SCHED; PG8_LDA(At, 1, 0); PG8_STAGE(PG8_SA(0, 1), a2 + hstep, voffA);
            PG8_WAIT_V(8); PG8_WAIT_L(0); PG8_BAR; PG8_MMA(0, 0, At, B0); PG8_MMA(0, 1, At, B1); PG8_BAR; PG8_SCHED;
            PG8_LDA(At, 1, 1); PG8_STAGE(PG8_SB(1, 0), b3, voffB); PG8_STAGE(PG8_SB(1, 1), b3 + hstep, voffB); PG8_STAGE(PG8_SA(1, 0), a3, voffA);
            PG8_WAIT_V(8); PG8_WAIT_L(0); PG8_BAR; PG8_MMA(1, 0, At, B0); PG8_MMA(1, 1, At, B1); PG8_BAR; PG8_SCHED;
            } else {
            PG8_LDB(B0, 0, 0); PG8_SCHED; PG8_LDA(At, 0, 0); PG8_STAGE(PG8_SA(1, 1), a1 + hstep, voffA);
            PG8_WAIT_L(8); PG8_BAR; PG8_WAIT_L(0); PG8_MMA(0, 0, At, B0); PG8_BAR; PG8_SCHED;
            PG8_LDB(B1, 0, 1); PG8_STAGE(PG8_SB(0, 0), b2, voffB);
            PG8_BAR; PG8_WAIT_L(0); PG8_MMA(0, 1, At, B1); PG8_BAR;
            PG8_LDA(At, 0, 1); PG8_STAGE(PG8_SA(0, 0), a2, voffA);
            PG8_BAR; PG8_WAIT_L(0); PG8_MMA(1, 0, At, B0); PG8_BAR; PG8_SCHED;
            PG8_STAGE(PG8_SB(0, 1), b2 + hstep, voffB);
            PG8_WAIT_V(6); PG8_BAR; PG8_MMA(1, 1, At, B1); PG8_BAR;
            PG8_LDB(B0, 1, 0); PG8_SCHED; PG8_LDA(At, 1, 0); PG8_STAGE(PG8_SA(0, 1), a2 + hstep, voffA);
            PG8_WAIT_L(8); PG8_BAR; PG8_WAIT_L(0); PG8_MMA(0, 0, At, B0); PG8_BAR; PG8_SCHED;
            PG8_LDB(B1, 1, 1); PG8_STAGE(PG8_SB(1, 0), b3, voffB);
            PG8_BAR; PG8_WAIT_L(0); PG8_MMA(0, 1, At, B1); PG8_BAR;
            PG8_LDA(At, 1, 1); PG8_STAGE(PG8_SA(1, 0), a3, voffA);
            PG8_BAR; PG8_WAIT_L(0); PG8_MMA(1, 0, At, B0); PG8_BAR; PG8_SCHED;
            PG8_STAGE(PG8_SB(1, 1), b3 + hstep, voffB);
            PG8_WAIT_V(6); PG8_BAR; PG8_MMA(1, 1, At, B1); PG8_BAR;
            }
        }
        if constexpr (ALIGN_EPI) { if (wr == 0) PG8_BAR; }
        if constexpr (!Epi::AFTER_DRAIN) { E(acc, cur, wr, wc, fr, fq); S.done(cur); }
        if (!has_next) break;
#pragma unroll
        for (int a = 0; a < 2; ++a)
#pragma unroll
            for (int b = 0; b < 2; ++b)
#pragma unroll
                for (int m = 0; m < 4; ++m)
#pragma unroll
                    for (int n = 0; n < 2; ++n) acc[a][b][m][n] = (f32x4){0.f, 0.f, 0.f, 0.f};
        cur = nxt; cA = nA; cB = nB; ++ui;
        if constexpr (ALIGN_EPI) { if (wr == 1) PG8_BAR; }
    }
    PG8_WAIT_V(0);
    if constexpr (!ALIGN_EPI) { if (wr == 0) PG8_BAR; }
    PG8_BAR;
    if constexpr (Epi::AFTER_DRAIN) { E.fused(acc, cur, wr, wc, fr, fq, lds, wid, lane); S.done(cur); }
#undef PG8_SA
#undef PG8_SB
#undef PG8_STAGE
#undef PG8_LDA
#undef PG8_LDB
#undef PG8_MMA
#undef PG8_WAIT_V
#undef PG8_WAIT_L
#undef PG8_BAR
#undef PG8_SCHED
}
}
#define LAS __attribute__((address_space(3)))
typedef unsigned short bf16;
typedef float f32x4 __attribute__((ext_vector_type(4)));
typedef float f32x2v __attribute__((ext_vector_type(2)));
typedef float f32x16 __attribute__((ext_vector_type(16)));
typedef unsigned v4u __attribute__((ext_vector_type(4)));
typedef unsigned v2u __attribute__((ext_vector_type(2)));
typedef short bf16x8 __attribute__((ext_vector_type(8)));
using pg8::cvt_pk_bf16;
__device__ __forceinline__ float bflo(unsigned w) { return __uint_as_float(w << 16); }
__device__ __forceinline__ float bfhi(unsigned w) { return __uint_as_float(w & 0xffff0000u); }
__device__ __forceinline__ float wave_sum(float v) {
#pragma unroll
    for (int o = 1; o < 64; o <<= 1) v += __shfl_xor(v, o);
    return v;
}

constexpr int VT_STR = 144;
template <int DQK, bool ROPEQ, bool VTR>
__device__ __forceinline__ void attn_unit(LAS unsigned char* lds,
        const bf16* Qb, long q_pitch, const bf16* Kb, long k_pitch, const bf16* Kpe, long kpe_pitch, const bf16* Vb, long v_pitch,
        bf16* Ob, long o_pitch, float* lse, long lse_pitch, int q0, int W, float sc2, float slope2, const f32x2v* rope, const int tid_in) {
    constexpr int KSTR = DQK * 2 + 16;
    constexpr int ND0 = DQK / 16;
    LAS unsigned char* Kt = lds;
    LAS unsigned char* Vt = lds + 64 * KSTR;
    int tid_ = tid_in; asm volatile("" : "+v"(tid_));
    const int tid = tid_, lane = tid & 63, r32 = lane & 31, hi = lane >> 5; const int wid = __builtin_amdgcn_readfirstlane(tid >> 6);
    const int qlo = q0 + 32 * wid, qrow = qlo + r32;
    bf16x8 qf[ND0];
    { const bf16* qp = Qb + (long)qrow * q_pitch + 8 * hi;
#pragma unroll
      for (int d0 = 0; d0 < ND0; ++d0) qf[d0] = *(const bf16x8*)(qp + 16 * d0); }
    if constexpr (ROPEQ) {
#pragma unroll
        for (int dp = 0; dp < 2; ++dp) {
            const f32x2v* rp = rope + (long)qrow * 32 + 16 * dp + 8 * hi;
            bf16x8 x1 = qf[8 + dp], x2 = qf[10 + dp]; bf16x8 y1, y2;
#pragma unroll
            for (int j = 0; j < 8; j += 2) {
                const f32x2v cs0 = rp[j], cs1 = rp[j + 1];
                const float a0 = __uint_as_float(((unsigned)(unsigned short)x1[j]) << 16), a1 = __uint_as_float(((unsigned)(unsigned short)x1[j + 1]) << 16);
                const float b0 = __uint_as_float(((unsigned)(unsigned short)x2[j]) << 16), b1 = __uint_as_float(((unsigned)(unsigned short)x2[j + 1]) << 16);
                const unsigned w1 = cvt_pk_bf16(a0 * cs0.x - b0 * cs0.y, a1 * cs1.x - b1 * cs1.y);
                const unsigned w2 = cvt_pk_bf16(b0 * cs0.x + a0 * cs0.y, b1 * cs1.x + a1 * cs1.y);
                y1[j] = (short)(w1 & 0xffffu); y1[j + 1] = (short)(w1 >> 16); y2[j] = (short)(w2 & 0xffffu); y2[j + 1] = (short)(w2 >> 16);
            }
            qf[8 + dp] = y1; qf[10 + dp] = y2;
        }
    }
    f32x16 o[4];
#pragma unroll
    for (int i = 0; i < 4; ++i) o[i] = f32x16{};
    float m_run = -1e30f, l_run = 0.f;
    const int kt_hi = (q0 >> 6) + 3; int kt_lo = (q0 - W) >> 6; if (kt_lo < 0) kt_lo = 0;
    const int kr0 = tid >> 4, kc0 = tid & 15;
    const int pr = tid >> 3, pc = tid & 7;
    const int vc0 = wid, vc1 = wid + 8;
    v4u kreg0, kreg1, preg = (v4u){0u, 0u, 0u, 0u}, vreg0, vreg1;
    const unsigned koff0 = (unsigned)((kr0 * k_pitch + 8 * kc0) * 2), koff1 = (unsigned)(((kr0 + 32) * k_pitch + 8 * kc0) * 2), poff = (unsigned)((pr * kpe_pitch + 8 * pc) * 2);
    const unsigned voff0 = VTR ? (unsigned)(((tid >> 3) * v_pitch + (tid & 7) * 8) * 2) : (unsigned)((lane * v_pitch + 8 * vc0) * 2), voff1 = VTR ? voff0 + (unsigned)(64 * v_pitch * 2) : voff0 + 128u;
#define ATT_LOAD(kt) do { const char* kb_ = (const char*)Kb + (size_t)(kt) * 128 * (size_t)k_pitch; const char* vb_ = (const char*)Vb + (VTR ? (size_t)(kt) * 128 : (size_t)(kt) * 128 * (size_t)v_pitch); \
        kreg0 = *(const v4u*)(kb_ + koff0); kreg1 = *(const v4u*)(kb_ + koff1); \
        if constexpr (DQK == 192) { const char* pb_ = (const char*)Kpe + (size_t)(kt) * 128 * (size_t)kpe_pitch; preg = *(const v4u*)(pb_ + poff); } \
        vreg0 = *(const v4u*)(vb_ + voff0); vreg1 = *(const v4u*)(vb_ + voff1); } while (0)
    constexpr int TILE_BYTES = 64 * KSTR + 128 * VT_STR;
    const int pir = (r32 & ~12) | ((r32 & 4) << 1) | ((r32 & 8) >> 1);
    const LAS unsigned char* kread0 = Kt + pir * KSTR + hi * 16;
    const LAS unsigned char* vread0 = Vt + r32 * VT_STR + hi * 16;
#define ATT_STAGE(boff) do { LAS unsigned char* kt_ = Kt + (boff); LAS unsigned char* vt_ = Vt + (boff); \
        *(LAS v4u*)(kt_ + kr0 * KSTR + kc0 * 16) = kreg0; *(LAS v4u*)(kt_ + (kr0 + 32) * KSTR + kc0 * 16) = kreg1; \
        if constexpr (DQK == 192) *(LAS v4u*)(kt_ + pr * KSTR + 256 + pc * 16) = preg; \
        if constexpr (VTR) { *(LAS v4u*)(vt_ + (tid >> 3) * VT_STR + (tid & 7) * 16) = vreg0; *(LAS v4u*)(vt_ + ((tid >> 3) + 64) * VT_STR + (tid & 7) * 16) = vreg1; } \
        else { LAS unsigned short* v0p = (LAS unsigned short*)(vt_ + (8 * vc0) * VT_STR + lane * 2); LAS unsigned short* v1p = (LAS unsigned short*)(vt_ + (8 * vc1) * VT_STR + lane * 2); \
            _Pragma("unroll") for (int j = 0; j < 4; ++j) { \
                v0p[(2 * j) * (VT_STR / 2)] = (unsigned short)(vreg0[j] & 0xffffu); v0p[(2 * j + 1) * (VT_STR / 2)] = (unsigned short)(vreg0[j] >> 16); \
                v1p[(2 * j) * (VT_STR / 2)] = (unsigned short)(vreg1[j] & 0xffffu); v1p[(2 * j + 1) * (VT_STR / 2)] = (unsigned short)(vreg1[j] >> 16); } } } while (0)
    ATT_LOAD(kt_lo);
    __syncthreads();
    ATT_STAGE(0);
    if (kt_lo < kt_hi) ATT_LOAD(kt_lo + 1);
    __syncthreads();
    if (wid >= 4) __builtin_amdgcn_s_setprio(1);
#pragma unroll 1
    for (int kt = kt_lo; kt <= kt_hi; ++kt) {
        const int boff = ((kt - kt_lo) & 1) * TILE_BYTES;
        const LAS unsigned char* kread = kread0 + boff; const LAS unsigned char* vread = vread0 + boff;
        const int k0 = kt * 64;
        if (!(k0 > qlo + 31 || k0 + 63 < qlo - W)) {
        f32x16 p0 = f32x16{}, p1 = f32x16{};
#pragma unroll
        for (int d0 = 0; d0 < ND0; ++d0) {
            const bf16x8 a0 = *(const LAS bf16x8*)(kread + d0 * 32), a1 = *(const LAS bf16x8*)(kread + 32 * KSTR + d0 * 32);
            p0 = __builtin_amdgcn_mfma_f32_32x32x16_bf16(a0, qf[d0], p0, 0, 0, 0);
            p1 = __builtin_amdgcn_mfma_f32_32x32x16_bf16(a1, qf[d0], p1, 0, 0, 0);
        }
        const bool need_mask = (k0 + 63 > qlo) || (k0 < qlo + 31 - W);
        const int dbase = qrow - k0 - 8 * hi;
        float mx = -INFINITY;
        if (slope2 != 0.f) {
            const float sr = slope2 / sc2, b0 = -sr * (float)dbase;
#pragma unroll
            for (int r = 0; r < 16; ++r) { const float c = (float)(16 * (r >> 3) + (r & 7)); p0[r] += __builtin_fmaf(sr, c, b0); p1[r] += __builtin_fmaf(sr, c + 32.0f, b0); }
        }
        if (need_mask) {
#pragma unroll
            for (int r = 0; r < 16; ++r) { const int c = 16 * (r >> 3) + (r & 7);
                if ((unsigned)(dbase - c) > (unsigned)W) p0[r] = -INFINITY;
                if ((unsigned)(dbase - c - 32) > (unsigned)W) p1[r] = -INFINITY; }
        }
#pragma unroll
        for (int r = 0; r < 16; r += 2) mx = fmaxf(mx, fmaxf(fmaxf(p0[r], p0[r + 1]), fmaxf(p1[r], p1[r + 1])));
        mx = fmaxf(mx, __shfl_xor(mx, 32)) * sc2;
        const float m_new = fmaxf(m_run, mx), alpha = __builtin_amdgcn_exp2f(m_run - m_new);
        m_run = m_new;
        float rs = 0.f;
#pragma unroll
        for (int r = 0; r < 16; ++r) { p0[r] = __builtin_amdgcn_exp2f(__builtin_fmaf(p0[r], sc2, -m_new)); p1[r] = __builtin_amdgcn_exp2f(__builtin_fmaf(p1[r], sc2, -m_new)); rs += p0[r] + p1[r]; }
        l_run = l_run * alpha + rs;
#pragma unroll
        for (int i = 0; i < 4; ++i)
#pragma unroll
            for (int r = 0; r < 16; ++r) o[i][r] *= alpha;
        bf16x8 pf[4];
#pragma unroll
        for (int s = 0; s < 2; ++s) {
            v4u w0, w1;
            w0.x = cvt_pk_bf16(p0[8 * s + 0], p0[8 * s + 1]); w0.y = cvt_pk_bf16(p0[8 * s + 2], p0[8 * s + 3]); w0.z = cvt_pk_bf16(p0[8 * s + 4], p0[8 * s + 5]); w0.w = cvt_pk_bf16(p0[8 * s + 6], p0[8 * s + 7]);
            w1.x = cvt_pk_bf16(p1[8 * s + 0], p1[8 * s + 1]); w1.y = cvt_pk_bf16(p1[8 * s + 2], p1[8 * s + 3]); w1.z = cvt_pk_bf16(p1[8 * s + 4], p1[8 * s + 5]); w1.w = cvt_pk_bf16(p1[8 * s + 6], p1[8 * s + 7]);
            pf[s] = __builtin_bit_cast(bf16x8, w0); pf[2 + s] = __builtin_bit_cast(bf16x8, w1);
        }
#pragma unroll
        for (int db = 0; db < 4; ++db)
#pragma unroll
            for (int s = 0; s < 4; ++s) {
                const bf16x8 vf = *(const LAS bf16x8*)(vread + db * 32 * VT_STR + s * 32);
                o[db] = __builtin_amdgcn_mfma_f32_32x32x16_bf16(vf, pf[s], o[db], 0, 0, 0);
            }
        }
        if (kt < kt_hi) { ATT_STAGE(TILE_BYTES - boff); if (kt + 1 < kt_hi) ATT_LOAD(kt + 2); }
        __syncthreads();
    }
    __builtin_amdgcn_s_setprio(0);
#undef ATT_LOAD
#undef ATT_STAGE
    const float l_tot = l_run + __shfl_xor(l_run, 32), inv = 1.0f / l_tot;
    bf16* op = Ob + (long)qrow * o_pitch + 4 * hi;
#pragma unroll
    for (int db = 0; db < 4; ++db)
#pragma unroll
        for (int g = 0; g < 4; ++g) { v2u w; w.x = cvt_pk_bf16(o[db][4 * g] * inv, o[db][4 * g + 1] * inv); w.y = cvt_pk_bf16(o[db][4 * g + 2] * inv, o[db][4 * g + 3] * inv);
            *(v2u*)(op + 32 * db + 8 * g) = w; }
    if (lse != nullptr && hi == 0) lse[(long)qrow * lse_pitch] = (m_run + __builtin_amdgcn_logf(l_tot)) * 0.6931471805599453f;
}
constexpr int T = 16384, SEQ = 4096, DM = 2048, DFF = 5504, NUP = 2 * DFF;
constexpr int N_IN_PAD = 9728;
constexpr int UP_TILES_A = 24, UP_TILES_B = 19;
constexpr size_t MiB = 1u << 20;
constexpr size_t WS_RSTD0 = 0, WS_SSQQ = 65536, WS_SSQKV = 2 * 65536, WS_SSQ1 = 3 * 65536, WS_SSQ2 = 4 * 65536;
constexpr size_t WS_LSE = 1 * MiB;
constexpr size_t WS_ROPE = 2 * MiB;
constexpr size_t WS_WUQ = 3 * MiB;
constexpr size_t WS_WKV = WS_WUQ + 1536 * 512 * 2;
constexpr size_t WS_WOM = WS_WKV + 2048 * 256 * 2;
constexpr size_t WS_WOD = WS_WOM + 2048 * 1024 * 2;
constexpr size_t WS_WOUT = WS_WOD + 2048 * 512 * 2;
constexpr size_t WS_A = 19 * MiB + 512 * 1024;
constexpr size_t WS_C = 83 * MiB + 512 * 1024;
constexpr size_t WS_WIN = WS_C, WS_V = WS_C;
constexpr size_t WS_CQ = 122 * MiB, WS_CKV = 138 * MiB, WS_KPER = 146 * MiB;
constexpr size_t WS_WDN = WS_C, WS_WUP = WS_WDN + (size_t)DM * DFF * 2;
constexpr size_t WS_E = 150 * MiB;
constexpr size_t WS_DQ = WS_E, WS_DK = WS_E + 48 * MiB, WS_DV = WS_E + 96 * MiB;
constexpr size_t WS_ATT = WS_E, WS_DIL = WS_E + 32 * MiB;
constexpr size_t WS_GA = 294 * MiB, WS_GB = 358 * MiB;
constexpr size_t WS_G = 422 * MiB;
constexpr size_t WS_Q = WS_G, WS_KN = WS_G + 48 * MiB, WS_KPE = WS_G + 80 * MiB, WS_MERGEB = WS_G;
constexpr size_t WS_U = 148 * MiB;
constexpr size_t WS_ACT = 340 * MiB;
constexpr size_t WS_END = 512 * MiB;
static_assert(WS_WOUT + (size_t)DM * DM * 2 <= WS_A && WS_A + 64 * MiB <= WS_C && WS_C + 38 * MiB <= WS_CQ, "small weights / A / C");
static_assert(WS_WUP + (size_t)NUP * DM * 2 <= WS_U, "wup");
static_assert((size_t)T * UP_TILES_A * 256 * 2 == 192 * MiB, "U");
constexpr size_t WS_ACT_REAL = WS_U + 192 * MiB;
static_assert(WS_ACT_REAL + (size_t)T * DFF * 2 <= WS_END, "ACT must fit");

struct Args { const float* in[17]; float* out; unsigned char* ws; int ph_lo, ph_hi, coop, pad; };

__device__ __forceinline__ int map_row(int code, int n) {
    switch (code) {
        case 1: return n < 832 ? n : n + 192;
        case 2: { const int h = n >> 8, j = n & 255; return j < 128 ? h * 128 + j : 1024 + h * 128 + (j - 128); }
        case 3: { const int gate = n >= DFF ? 1 : 0, c = n - gate * DFF; return (c >> 7) * 256 + gate * 128 + (c & 127); }
        default: return n;
    }
}
__device__ __forceinline__ void conv_item(const float* W, int K, int N, bf16* WT, int ldk, int kofs, const float* g, int code, LAS float* scr, int item, int lane) {
    const int nblk = N / 32, kb = item / nblk, nb = item % nblk, k0 = 64 * kb, n0 = 32 * nb;
    const int drow0 = map_row(code, n0);
    const int c = lane & 7;
    f32x4 g0 = (f32x4){1.f, 1.f, 1.f, 1.f}, g1 = g0;
    if (g) { g0 = *(const f32x4*)(g + k0 + 8 * c); g1 = *(const f32x4*)(g + k0 + 8 * c + 4); }
    { float wv[32]; const float* wp = W + (size_t)(k0 + (lane >> 5)) * N + n0 + (lane & 31);
#pragma unroll
      for (int i = 0; i < 32; ++i) wv[i] = wp[(size_t)(2 * i) * N];
#pragma unroll
      for (int i = 0; i < 32; ++i) { const int kk = 2 * i + (lane >> 5); scr[kk * 33 + (lane & 31)] = wv[i]; } }
    asm volatile("s_waitcnt lgkmcnt(0)" ::: "memory");
#pragma unroll
    for (int j = 0; j < 4; ++j) { const int n = (lane >> 3) + 8 * j; const LAS float* s = scr + (8 * c) * 33 + n;
        v4u o; o.x = cvt_pk_bf16(s[0 * 33] * g0[0], s[1 * 33] * g0[1]); o.y = cvt_pk_bf16(s[2 * 33] * g0[2], s[3 * 33] * g0[3]); o.z = cvt_pk_bf16(s[4 * 33] * g1[0], s[5 * 33] * g1[1]); o.w = cvt_pk_bf16(s[6 * 33] * g1[2], s[7 * 33] * g1[3]);
        *(v4u*)(WT + (size_t)(drow0 + n) * ldk + kofs + k0 + 8 * c) = o; }
    asm volatile("s_waitcnt lgkmcnt(0)" ::: "memory");
}
__device__ __forceinline__ void conv_matrix(const float* W, int K, int N, bf16* WT, int ldk, int kofs, const float* g, int code, LAS float* scr, int gw, int NGW, int lane) {
    const int nitems = (K / 64) * (N / 32);
    for (int it = gw; it < nitems; it += NGW) conv_item(W, K, N, WT, ldk, kofs, g, code, scr, it, lane);
}
__device__ __forceinline__ void conv_matrix_wg(const float* W, int K, int N, bf16* WT, int ldk, int kofs, const float* g, int code, LAS unsigned char* lds, int bid, int G, int tid, int& rot) {
    const int nblk = (N + 255) / 256, nitems = (K / 64) * nblk;
    const int lane = tid & 63, w = tid >> 6, c = tid & 7;
    int first = bid - rot; if (first < 0) first += G;
    for (int it = first; it < nitems; it += 2 * G) {
        const int it2 = it + G; const bool two = it2 < nitems;
        float v[2][32]; int k0s[2], n0s[2];
#pragma unroll
        for (int q = 0; q < 2; ++q) {
            const int iq = q == 0 ? it : (two ? it2 : it);
            const int kb = iq / nblk, nb = iq - kb * nblk; k0s[q] = 64 * kb; n0s[q] = 256 * nb;
            const float* wp = W + (size_t)(k0s[q] + 8 * w) * N + n0s[q] + lane;
            if (q == 0 || two) {
#pragma unroll
                for (int i = 0; i < 8; ++i)
#pragma unroll
                    for (int e = 0; e < 4; ++e) v[q][i * 4 + e] = (n0s[q] + lane + 64 * e < N) ? wp[(size_t)i * N + 64 * e] : 0.f;
            }
        }
        __syncthreads();
#pragma unroll
        for (int q = 0; q < 2; ++q) { LAS float* Tt = (LAS float*)lds + q * (64 * 257);
            if (q == 0 || two) {
#pragma unroll
                for (int i = 0; i < 8; ++i)
#pragma unroll
                    for (int e = 0; e < 4; ++e) Tt[(8 * w + i) * 257 + lane + 64 * e] = v[q][i * 4 + e];
            } }
        __syncthreads();
#pragma unroll
        for (int q = 0; q < 2; ++q) { const LAS float* Tt = (const LAS float*)lds + q * (64 * 257);
            if (q == 0 || two) {
                const int k0 = k0s[q], n0 = n0s[q];
                f32x4 g0 = (f32x4){1.f, 1.f, 1.f, 1.f}, g1 = g0;
                if (g) { g0 = *(const f32x4*)(g + k0 + 8 * c); g1 = *(const f32x4*)(g + k0 + 8 * c + 4); }
#pragma unroll
                for (int j = 0; j < 4; ++j) { const int n = (tid >> 3) + 64 * j;
                    if (n0 + n < N) { const LAS float* s = Tt + (8 * c) * 257 + n; const int drow = map_row(code, n0 + n);
                        v4u o; o.x = cvt_pk_bf16(s[0 * 257] * g0[0], s[1 * 257] * g0[1]); o.y = cvt_pk_bf16(s[2 * 257] * g0[2], s[3 * 257] * g0[3]); o.z = cvt_pk_bf16(s[4 * 257] * g1[0], s[5 * 257] * g1[1]); o.w = cvt_pk_bf16(s[6 * 257] * g1[2], s[7 * 257] * g1[3]);
                        *(v4u*)(WT + (size_t)drow * ldk + kofs + k0 + 8 * c) = o; } }
            } }
    }
    rot = (rot + nitems) % G;
    __syncthreads();
}
__device__ __forceinline__ void row_to_bf16_rstd(const float* xrow, bf16* orow, float* rstd_out, int lane) {
    const f32x4* xr = (const f32x4*)xrow + lane; f32x4 v[8]; float s = 0.f;
#pragma unroll
    for (int j = 0; j < 8; ++j) { v[j] = xr[64 * j]; s += (v[j].x * v[j].x + v[j].y * v[j].y) + (v[j].z * v[j].z + v[j].w * v[j].w); }
    s = wave_sum(s);
    if (lane == 0) *rstd_out = rsqrtf(s * (1.0f / DM) + 1e-6f);
    v2u* o8 = (v2u*)orow + lane;
#pragma unroll
    for (int j = 0; j < 8; ++j) { v2u w; w.x = cvt_pk_bf16(v[j].x, v[j].y); w.y = cvt_pk_bf16(v[j].z, v[j].w); o8[64 * j] = w; }
}

#define XB_TMO      128
#define XB_XCNT(j)  (256  + 64 * (j))
#define XB_XSUB(j)  (1280 + 64 * (j))
#define XB_XGEN(j)  (2304 + 64 * (j))
#define XB_TOP      3328
#define XB_TOPGEN   3392
#define XCD_BAR_WORDS 3456
#define XB_SPIN_CAP (1u << 20)
__device__ __forceinline__ unsigned xb_ld(unsigned* p)              { return __hip_atomic_load(p, __ATOMIC_RELAXED, __HIP_MEMORY_SCOPE_AGENT); }
__device__ __forceinline__ unsigned xb_add(unsigned* p, unsigned v) { return __hip_atomic_fetch_add(p, v, __ATOMIC_RELAXED, __HIP_MEMORY_SCOPE_AGENT); }
__device__ __forceinline__ unsigned xb_xcc_id() { return (unsigned)__builtin_amdgcn_s_getreg((3 << 11) | 20) & 0xFu; }
#define XB_SPIN(cond, bar) do { unsigned _sp = 0; while (cond) { __builtin_amdgcn_s_sleep(1); \
    if ((++_sp & 255u) == 0u) { if (xb_ld(&(bar)[XB_TMO])) break; if (_sp > XB_SPIN_CAP) { atomicAdd(&(bar)[XB_TMO], 1u); break; } } } } while (0)
__device__ __forceinline__ void xcd_barrier_complete(unsigned* bar, unsigned x, unsigned G, unsigned& nloc, unsigned& nx) {
    unsigned sum, cnt, mine, sp = 0u;
    for (;;) {
        sum = 0u; cnt = 0u; mine = 0u;
#pragma unroll
        for (unsigned j = 0; j < 16; ++j) { const unsigned c = xb_ld(&bar[XB_XCNT(j)]); sum += c; cnt += (c > 0u) ? 1u : 0u; mine = (j == x) ? c : mine; }
        if (sum == G) break;
        __builtin_amdgcn_s_sleep(1);
        if ((++sp & 255u) == 0u) { if (xb_ld(&bar[XB_TMO])) break; if (sp > XB_SPIN_CAP) { atomicAdd(&bar[XB_TMO], 1u); break; } }
    }
    nloc = mine > 0u ? mine : 1u; nx = cnt > 0u ? cnt : 1u;
}
__device__ __forceinline__ void xcd_barrier(unsigned* bar, volatile LAS unsigned* st, unsigned G, bool leader) {
    asm volatile("s_waitcnt vmcnt(0)" ::: "memory");
    __syncthreads();
    if (leader) {
        const unsigned x = xb_xcc_id();
        __builtin_amdgcn_s_waitcnt(0);
        unsigned nloc = st[0], nx = st[1];
        if (nloc == 0u) { xcd_barrier_complete(bar, x, G, nloc, nx); st[0] = nloc; st[1] = nx; }
        const unsigned old = xb_add(&bar[XB_XSUB(x)], 1u);
        const unsigned gen = old / nloc;
        if (old + 1u == (gen + 1u) * nloc) {
            __builtin_amdgcn_fence(__ATOMIC_RELEASE, "agent");
            asm volatile("s_waitcnt vmcnt(0)" ::: "memory");
            const unsigned og = xb_add(&bar[XB_TOP], 1u);
            const unsigned tg = og / nx;
            if (og + 1u == (tg + 1u) * nx) xb_add(&bar[XB_TOPGEN], 1u);
            else XB_SPIN(xb_ld(&bar[XB_TOPGEN]) == tg, bar);
            __builtin_amdgcn_fence(__ATOMIC_ACQUIRE, "agent");
            xb_add(&bar[XB_XGEN(x)], 1u);
            asm volatile("s_waitcnt vmcnt(0)" ::: "memory");
        } else {
            XB_SPIN(xb_ld(&bar[XB_XGEN(x)]) == gen, bar);
            __builtin_amdgcn_fence(__ATOMIC_ACQUIRE, "agent");
            asm volatile("s_waitcnt vmcnt(0)" ::: "memory");
        }
    }
    __syncthreads();
}

__device__ __forceinline__ bool unit_of(int M, int N, int G, int c, int i, int& pm, int& pn) {
    const int nM = M / 256, nN = N / 256, nwg = nM * nN; const long L = (long)i * G + c; if (L >= nwg) return false;
    int wgid = (int)L; { const int q = nwg / 8, r = nwg % 8, xcd = wgid % 8, off = wgid / 8; wgid = (xcd < r ? xcd * (q + 1) : r * (q + 1) + (xcd - r) * q) + off; }
    const int nig = 8 * nN, gid = wgid / nig, fm = gid * 8, gsz = (nM - fm) < 8 ? (nM - fm) : 8;
    pm = fm + ((wgid % nig) % gsz); pn = (wgid % nig) / gsz; return true;
}
__device__ __forceinline__ int lane_id_fresh() { int l; asm volatile("v_mbcnt_lo_u32_b32 %0, -1, 0\n\tv_mbcnt_hi_u32_b32 %0, -1, %0" : "=v"(l)); return l; }

constexpr int LDS_BYTES = 147456;
__global__ void __launch_bounds__(512, 2) fwd_mega(Args args) {
    extern __shared__ __attribute__((aligned(16))) unsigned char lds_raw[];
    LAS unsigned char* lds = (LAS unsigned char*)lds_raw;
    cg::grid_group grid = cg::this_grid();
    const int G = gridDim.x, bid = blockIdx.x;
    const int wave0 = __builtin_amdgcn_readfirstlane((int)threadIdx.x >> 6);
#define MKTID() (wave0 * 64 + lane_id_fresh())
    unsigned* BARW = (unsigned*)(args.ws + 6 * 65536);
    volatile LAS unsigned* BARST = (volatile LAS unsigned*)(lds + 139264);
    if (threadIdx.x == 0) { BARST[0] = 0u; BARST[1] = 0u; if (args.coop) (void)xb_add(&BARW[XB_XCNT(xb_xcc_id())], 1u); }
    __syncthreads();
#define GBAR() xcd_barrier(BARW, BARST, (unsigned)G, MKTID() == 0)
    const int NGW = G * 8, NGT = G * 512;
#define FRESH() int tid = MKTID(); asm volatile("" : "+v"(tid)); const int lane = tid & 63; const int wave = __builtin_amdgcn_readfirstlane(tid >> 6); \
    const int gw = bid * 8 + wave; const int gt = bid * 512 + tid; LAS float* scr = (LAS float*)(lds + wave * 16384); (void)lane; (void)gw; (void)gt; (void)scr
    unsigned char* ws = args.ws;
    const float* x = args.in[0]; const float* attn_norm_g = args.in[1]; const float* w_in = args.in[2]; const float* b_gate = args.in[3];
    const float* q_norm_g = args.in[4]; const float* w_uq = args.in[5]; const float* kv_norm_g = args.in[6]; const float* w_ukv = args.in[7];
    const float* w_o_mla = args.in[8]; const float* w_o_dil = args.in[9]; const float* w_out = args.in[10]; const float* ffn_norm_g = args.in[11];
    const float* w_up = args.in[12]; const float* conv_w = args.in[13]; const float* conv_b = args.in[14]; const float* w_down = args.in[15]; const float* final_norm_g = args.in[16];
    float* out = args.out;
    float* RSTD0 = (float*)(ws + WS_RSTD0); float* SSQQ = (float*)(ws + WS_SSQQ); float* SSQKV = (float*)(ws + WS_SSQKV); float* SSQ1 = (float*)(ws + WS_SSQ1); float* SSQ2 = (float*)(ws + WS_SSQ2);
    float* LSE = (float*)(ws + WS_LSE); f32x2v* ROPE = (f32x2v*)(ws + WS_ROPE);
    bf16* WUQ = (bf16*)(ws + WS_WUQ); bf16* WKV = (bf16*)(ws + WS_WKV); bf16* WOM = (bf16*)(ws + WS_WOM); bf16* WOD = (bf16*)(ws + WS_WOD); bf16* WOUT = (bf16*)(ws + WS_WOUT);
    bf16* WIN = (bf16*)(ws + WS_WIN); bf16* WDN = (bf16*)(ws + WS_WDN); bf16* WUP = (bf16*)args.out;
    bf16* XB = (bf16*)(ws + WS_A); bf16* OG = (bf16*)(ws + WS_A); bf16* X1B = (bf16*)(ws + WS_A);
    bf16* CQ = (bf16*)(ws + WS_CQ); bf16* CKV = (bf16*)(ws + WS_CKV); float* KPER = (float*)(ws + WS_KPER);
    bf16* DQ = (bf16*)(ws + WS_DQ); bf16* DK = (bf16*)(ws + WS_DK); bf16* DV = (bf16*)(ws + WS_DV);
    bf16* ATT = (bf16*)(ws + WS_ATT); bf16* DIL = (bf16*)(ws + WS_DIL);
    bf16* GA = (bf16*)(ws + WS_GA); bf16* GB = (bf16*)(ws + WS_GB);
    bf16* Q = (bf16*)(ws + WS_Q); bf16* KN = (bf16*)(ws + WS_KN); bf16* KPE = (bf16*)(ws + WS_KPE); bf16* V = (bf16*)(ws + WS_V); bf16* MERGEB = (bf16*)(ws + WS_MERGEB);
    bf16* U = (bf16*)(ws + WS_U); bf16* ACT = (bf16*)(ws + WS_ACT_REAL); float* HEADB = (float*)(ws + WS_U); float* TAILB = (float*)(ws + WS_U + 8 * MiB);
    float* MERGE = out;
    float* X1 = (float*)(ws + 164 * MiB);

    const int lo = args.ph_lo, hi = args.ph_hi;
#define IN(k) (lo <= (k) && (k) < hi)
#ifndef PROBE_DUP
#define PROBE_DUP 0
#endif
#define NREP(k) (((PROBE_DUP >> (k)) & 1) + 1)
#define REPSYNC() do { if (rep && args.coop) GBAR(); } while (0)
#define SEAM(k) do { if (IN(k) && IN((k) + 1)) { if (args.coop) { if ((k) == 0 && args.pad == 0x7fffffff) grid.sync();     \
        GBAR(); } } } while (0)
    float* DUMMY = (float*)(ws + 5 * 65536);

    if (IN(0)) for (int rep = 0; rep < NREP(0); ++rep) { REPSYNC(); FRESH(); int rot = 0;
        conv_matrix_wg(w_in, DM, 9536, WIN, DM, 0, attn_norm_g, 1, lds, bid, G, tid, rot);
        if (G != 256) {
        conv_matrix_wg(w_uq, 512, 1536, WUQ, 512, 0, q_norm_g, 0, lds, bid, G, tid, rot);
        conv_matrix_wg(w_ukv, 256, 2048, WKV, 256, 0, kv_norm_g, 2, lds, bid, G, tid, rot);
        conv_matrix_wg(w_o_mla, 1024, 2048, WOM, 1536, 0, nullptr, 0, lds, bid, G, tid, rot);
        conv_matrix_wg(w_o_dil, 512, 2048, WOM, 1536, 1024, nullptr, 0, lds, bid, G, tid, rot);
        conv_matrix_wg(w_out, 2048, 2048, WOUT, DM, 0, nullptr, 0, lds, bid, G, tid, rot);
        }
        for (int m = gw; m < T; m += NGW) row_to_bf16_rstd(x + (size_t)m * DM, XB + (size_t)m * DM, RSTD0 + m, lane);
        for (int i = gt; i < 4 * T; i += NGT) SSQQ[i] = 0.f;
        if (G != 256) for (int i = gt; i < SEQ * 32; i += NGT) { const int pos = i >> 5, f = i & 31; const float inv_freq = powf(10000.0f, -(float)(2 * f) / 64.0f); const float ang = (float)pos * inv_freq;
            float sn, cs; sincosf(ang, &sn, &cs); ROPE[i] = (f32x2v){cs, sn}; }
    }
    SEAM(0);
    if (IN(1)) for (int rep = 0; rep < NREP(1); ++rep) { REPSYNC();
        pg8::Gemm g{XB, WIN, T, N_IN_PAD, DM}; pg8::StaticOrder S; S.init(T, N_IN_PAD, G, bid);
        pg8::EpiProj E{CQ, CKV, DQ, DK, DV, GA, GB, KPER, RSTD0, rep ? nullptr : SSQQ, rep ? nullptr : SSQKV, b_gate};
        pg8::gemm_phase<pg8::EpiProj, pg8::StaticOrder, true, true>(lds, g, S, E, MKTID());
        if (G == 256 && bid >= 128 && rep == 0) {
            FRESH(); int rot = 0;
            conv_matrix_wg(w_uq, 512, 1536, WUQ, 512, 0, q_norm_g, 0, lds, bid - 128, 128, tid, rot);
            conv_matrix_wg(w_ukv, 256, 2048, WKV, 256, 0, kv_norm_g, 2, lds, bid - 128, 128, tid, rot);
            conv_matrix_wg(w_o_mla, 1024, 2048, WOM, 1536, 0, nullptr, 0, lds, bid - 128, 128, tid, rot);
            conv_matrix_wg(w_o_dil, 512, 2048, WOM, 1536, 1024, nullptr, 0, lds, bid - 128, 128, tid, rot);
            conv_matrix_wg(w_out, 2048, 2048, WOUT, DM, 0, nullptr, 0, lds, bid - 128, 128, tid, rot);
            conv_matrix_wg(w_up, DM, NUP, WUP, DM, 0, ffn_norm_g, 3, lds, bid - 128, 128, tid, rot);
            for (int i = (bid - 128) * 512 + tid; i < SEQ * 32; i += 128 * 512) { const int pos = i >> 5, f = i & 31; const float inv_freq = powf(10000.0f, -(float)(2 * f) / 64.0f); const float ang = (float)pos * inv_freq;
                float sn, cs; sincosf(ang, &sn, &cs); ROPE[i] = (f32x2v){cs, sn}; }
        }
    }
    SEAM(1);
    if (IN(2)) for (int rep = 0; rep < NREP(2); ++rep) { REPSYNC();
        { pg8::Gemm g{CQ, WUQ, T, 1536, 512}; pg8::StaticOrder S; S.init(T, 1536, G, bid);
          pg8::EpiRowScale E{Q, Q, 1000, 1536, SSQQ, 1.0f / 512.0f};
          pg8::gemm_phase<pg8::EpiRowScale, pg8::StaticOrder, true, true>(lds, g, S, E, MKTID()); }
        { pg8::Gemm g{CKV, WKV, T, 1024, 256}; pg8::StaticOrder S; S.init(T, 1024, G, (bid + 128) % G);
          pg8::EpiRowScale E{KN, KN, 1000, 1024, SSQKV, 1.0f / 256.0f};
          pg8::gemm_phase<pg8::EpiRowScale, pg8::StaticOrder, true, true>(lds, g, S, E, MKTID()); }
        { pg8::Gemm g{WKV + 1024 * 256, CKV, 1024, T, 256}; pg8::StaticOrder S; S.init(1024, T, G, bid);
          pg8::EpiColScale E{V, T, SSQKV, 1.0f / 256.0f};
          pg8::gemm_phase<pg8::EpiColScale, pg8::StaticOrder, true, true>(lds, g, S, E, MKTID()); }
        FRESH();
        for (int i = gt; i < T * 32; i += NGT) { const int t = i >> 5, f = i & 31; const float x1 = KPER[(size_t)t * 64 + f], x2 = KPER[(size_t)t * 64 + 32 + f]; const f32x2v cs = ROPE[(t & (SEQ - 1)) * 32 + f];
            KPE[(size_t)t * 64 + f] = (bf16)(cvt_pk_bf16(x1 * cs.x - x2 * cs.y, 0.f) & 0xffffu); KPE[(size_t)t * 64 + 32 + f] = (bf16)(cvt_pk_bf16(x2 * cs.x + x1 * cs.y, 0.f) & 0xffffu); }
        for (int uid = bid; uid < 768; uid += G) {
            const int g = uid >> 8, rem = uid & 255, b = rem >> 6, hs = (rem >> 4) & 3, sub = rem & 15;
            const int dil = g == 0 ? 1 : (g == 1 ? 4 : 16), nblk = 16 / dil, r = sub / nblk, ublk = sub % nblk;
            const float slope = exp2f(-8.0f * (float)(g * 4 + hs + 1) / 12.0f);
            const size_t rowb = (size_t)b * SEQ + r; const int colb = g * 512 + hs * 128;
#ifndef SKIP_DIL
            attn_unit<128, false, false>(lds, DQ + rowb * 1536 + colb, (long)dil * 1536, DK + rowb * 1536 + colb, (long)dil * 1536, nullptr, 0, DV + rowb * 1536 + colb, (long)dil * 1536,
                OG + (size_t)g * T * 512 + rowb * 512 + hs * 128, (long)dil * 512, LSE + ((size_t)g * T + rowb) * 4 + hs, (long)dil * 4, ublk * 256, 128,
                0.08838834764831845f * 1.4426950408889634f, slope * (float)dil * 1.4426950408889634f, nullptr, MKTID());
#endif
        }
    }
    SEAM(2);
    if (IN(3)) for (int rep = 0; rep < NREP(3); ++rep) { REPSYNC();
        for (int it = bid; it < 256; it += G) {
            const int bh = it >> 3, s = it & 7, b = bh >> 3, h = bh & 7;
            const size_t rowb = (size_t)b * SEQ;
#pragma unroll 1
            for (int k = 0; k < 2; ++k) { const int qb = k == 0 ? 15 - s : s;
#ifndef SKIP_MLA
                attn_unit<192, true, true>(lds, Q + rowb * 1536 + h * 192, 1536, KN + rowb * 1024 + h * 128, 1024, KPE + rowb * 64, 64, V + (size_t)(h * 128) * T + rowb, T,
                    ATT + rowb * 1536 + h * 128, 1536, nullptr, 0, qb * 256, 1 << 24, 0.07216878364870322f * 1.4426950408889634f, 0.f, ROPE, MKTID());
#endif
            }
        }
        FRESH();
        for (int i = gt; i < T * 64; i += NGT) {
            const int t = i >> 6, hs = (i >> 4) & 3, c = i & 15;
            const float l0 = LSE[(size_t)t * 4 + hs], l1 = LSE[((size_t)T + t) * 4 + hs], l2 = LSE[((size_t)2 * T + t) * 4 + hs];
            const float mx = fmaxf(l0, fmaxf(l1, l2)); float e0 = __expf(l0 - mx), e1 = __expf(l1 - mx), e2 = __expf(l2 - mx); const float inv = 1.0f / (e0 + e1 + e2); e0 *= inv; e1 *= inv; e2 *= inv;
            const size_t off = (size_t)t * 512 + hs * 128 + c * 8;
            const v4u a = *(const v4u*)(OG + off), b2 = *(const v4u*)(OG + (size_t)T * 512 + off), c2 = *(const v4u*)(OG + (size_t)2 * T * 512 + off); v4u o;
#pragma unroll
            for (int j = 0; j < 4; ++j) o[j] = cvt_pk_bf16(e0 * bflo(a[j]) + e1 * bflo(b2[j]) + e2 * bflo(c2[j]), e0 * bfhi(a[j]) + e1 * bfhi(b2[j]) + e2 * bfhi(c2[j]));
            *(v4u*)(ATT + (size_t)t * 1536 + 1024 + hs * 128 + c * 8) = o;
        }
    }
    SEAM(3);
    if (IN(4)) for (int rep = 0; rep < NREP(4); ++rep) { REPSYNC();
#ifndef PROBE_CONV
#define PROBE_CONV 1
#endif
        for (int r2 = 0; r2 < PROBE_CONV; ++r2) { FRESH(); int rot = 0;
        if (G != 256) conv_matrix_wg(w_up, DM, NUP, WUP, DM, 0, ffn_norm_g, 3, lds, bid, G, tid, rot);
        if (G != 256) conv_matrix_wg(w_down, DFF, DM, WDN, DFF, 0, nullptr, 0, lds, bid, G, tid, rot); }
        __syncthreads();
        { pg8::Gemm g{ATT, WOM, T, DM, 1536}; pg8::StaticOrder S; S.init(T, DM, G, bid);
          pg8::EpiMerge E{GA, GB, MERGEB, 16};
          pg8::gemm_phase<pg8::EpiMerge, pg8::StaticOrder, true, true>(lds, g, S, E, MKTID()); }
    }
    SEAM(4);
    if (IN(5)) for (int rep = 0; rep < NREP(5); ++rep) { REPSYNC();
        pg8::Gemm g{MERGEB, WOUT, T, DM, DM}; pg8::StaticOrder S; S.init(T, DM, G, bid);
        pg8::EpiResid E{x, X1, X1B, rep ? DUMMY : SSQ1};
        pg8::gemm_phase<pg8::EpiResid, pg8::StaticOrder, true, true>(lds, g, S, E, MKTID());
    }
    SEAM(5);
    if (IN(6)) for (int rep = 0; rep < NREP(6); ++rep) { REPSYNC();
        pg8::Gemm g{X1B, WUP, T, NUP, DM}; pg8::StaticOrder S; S.init(T, NUP, G, bid);
        pg8::EpiConvAct E{ACT, SSQ1, conv_w, conv_b, HEADB, TAILB, lds + 131072};
        pg8::gemm_phase<pg8::EpiConvAct, pg8::StaticOrder, true, true>(lds, g, S, E, MKTID());
        if (G == 256 && bid >= 192 && rep == 0) {
            FRESH(); int rot = 0;
            conv_matrix_wg(w_down, DFF, DM, WDN, DFF, 0, nullptr, 0, lds, bid - 192, 64, tid, rot);
        }
    }
    SEAM(6);
    if (IN(10)) for (int rep = 0; rep < NREP(10); ++rep) { REPSYNC();
        pg8::Gemm g{ACT, WDN, T, DM, DFF}; pg8::StaticOrder S; S.init(T, DM, G, bid);
        { FRESH();
#pragma unroll 1
          for (int i = 0; i < 64; ++i) { int pm, pn_; if (!unit_of(T, DM, G, bid, i, pm, pn_)) break; if ((pm & 15) == 0) continue;
            const float* tl = TAILB + (size_t)(pm - 1) * 2 * NUP; const float* hd = HEADB + (size_t)pm * 2 * NUP;
            for (int c = tid; c < DFF; c += 512) {
                const int colu = (c >> 7) * 256 + (c & 127), colg = colu + 128;
                const float um2 = tl[colu], um1 = tl[NUP + colu], u0 = hd[colu], u1 = hd[NUP + colu];
                const float gm2 = tl[colg], gm1 = tl[NUP + colg], g0 = hd[colg], g1 = hd[NUP + colg];
                const float wu0 = conv_w[c], wu1 = conv_w[NUP + c], wu2 = conv_w[2 * NUP + c], bu = conv_b[c];
                const float wg0 = conv_w[DFF + c], wg1 = conv_w[NUP + DFF + c], wg2 = conv_w[2 * NUP + DFF + c], bg = conv_b[DFF + c];
                const float cu0 = bu + wu0 * um2 + wu1 * um1 + wu2 * u0, cu1 = bu + wu0 * um1 + wu1 * u0 + wu2 * u1;
                const float cg0 = bg + wg0 * gm2 + wg1 * gm1 + wg2 * g0, cg1 = bg + wg0 * gm1 + wg1 * g0 + wg2 * g1;
                ACT[(size_t)(pm * 256) * DFF + c] = (bf16)(cvt_pk_bf16(cu0 * cg0 * __builtin_amdgcn_rcpf(1.0f + __expf(-cg0)), 0.f) & 0xffffu);
                ACT[(size_t)(pm * 256 + 1) * DFF + c] = (bf16)(cvt_pk_bf16(cu1 * cg1 * __builtin_amdgcn_rcpf(1.0f + __expf(-cg1)), 0.f) & 0xffffu);
            } }
          asm volatile("s_waitcnt vmcnt(0)" ::: "memory"); __syncthreads(); }
        pg8::EpiResid E{X1, out, nullptr, rep ? DUMMY : SSQ2};
        pg8::gemm_phase<pg8::EpiResid, pg8::StaticOrder, true, true>(lds, g, S, E, MKTID());
    }
    SEAM(10);
    if (IN(11)) { FRESH();
        for (int m = gw; m < T; m += NGW) {
            const float rs = rsqrtf(SSQ2[m] * (1.0f / DM) + 1e-6f);
            f32x4* xr = (f32x4*)(out + (size_t)m * DM) + lane; const f32x4* gr = (const f32x4*)final_norm_g + lane;
#pragma unroll
            for (int j = 0; j < 8; ++j) { const f32x4 v = xr[64 * j]; const f32x4 gg = gr[64 * j]; xr[64 * j] = v * rs * gg; }
        }
    }
#undef IN
#undef SEAM
}

#ifndef MK_N_LAUNCHES
#define MK_N_LAUNCHES 1
#endif
extern "C" void kernel_launch(void* const* d_in, const int* in_sizes, int n_in, void* d_out, int out_size, void* d_ws, size_t ws_size, hipStream_t stream) {
    static int grid = 0;
    if (grid == 0) {
        int dev = 0, cus = 0, per_cu = 0;
        if (n_in != 17 || out_size != T * DM || ws_size < WS_END) { fprintf(stderr, "kernel_launch: unexpected shapes / workspace (%d inputs, out %d, ws %zu)\n", n_in, out_size, ws_size); grid = -1; return; }
        (void)hipGetDevice(&dev);
        (void)hipDeviceGetAttribute(&cus, hipDeviceAttributeMultiprocessorCount, dev);
        (void)hipFuncSetAttribute((const void*)fwd_mega, hipFuncAttributeMaxDynamicSharedMemorySize, LDS_BYTES);
        (void)hipOccupancyMaxActiveBlocksPerMultiprocessor(&per_cu, (const void*)fwd_mega, 512, LDS_BYTES);
        if (per_cu < 1) per_cu = 1;
        grid = cus * per_cu;
        if (grid % 8 != 0 || grid < 8) grid = -1;
    }
    if (grid < 0) return;
    Args a{};
    for (int i = 0; i < 17; ++i) a.in[i] = (const float*)d_in[i];
    a.out = (float*)d_out; a.ws = (unsigned char*)d_ws;
#if MK_N_LAUNCHES == 1
    a.ph_lo = 0; a.ph_hi = 12; a.coop = 1;
    (void)hipMemsetAsync((unsigned char*)d_ws + 6 * 65536, 0, XCD_BAR_WORDS * 4, stream);
    void* kargs[] = {&a};
    hipError_t e = hipLaunchCooperativeKernel((const void*)fwd_mega, dim3(grid), dim3(512), kargs, LDS_BYTES, stream);
    if (e != hipSuccess) fprintf(stderr, "cooperative launch failed: %s (grid %d)\n", hipGetErrorString(e), grid);
#else
    for (int p = 0; p < 12; ++p) { a.ph_lo = p; a.ph_hi = p + 1; a.coop = 0; hipLaunchKernelGGL(fwd_mega, dim3(grid), dim3(512), LDS_BYTES, stream, a); }
#endif
}
```

```cpp
#include <hip/hip_runtime.h>
#include <hip/hip_cooperative_groups.h>
#include <cstdio>
#include <cstdint>
namespace cg = cooperative_groups;
namespace pg8 {
#define PG8_LAS __attribute__((address_space(3)))
typedef unsigned short bf16_t;
typedef short bf16x8 __attribute__((ext_vector_type(8)));
typedef float f32x4 __attribute__((ext_vector_type(4)));
typedef unsigned u32x4 __attribute__((ext_vector_type(4)));
constexpr int BM = 256, BK = 64, HALF = 128, HTB = HALF * BK * 2  , STAGE_BYTES = 8 * HTB, NXCD = 8, WGM = 4;

__host__ __device__ __forceinline__ int lds_byte(int r, int c) { const int st = (r >> 4) * 2 + (c >> 5), rr = r & 15, cc = c & 31, ob = rr * 64 + cc * 2; return st * 1024 + (ob ^ (((ob >> 9) & 1) << 5)); }
__host__ __device__ __forceinline__ void stage_rc(int b, int& R, int& C) { const int st = b / 1024, sb = b % 1024, swz = sb ^ (((sb >> 9) & 1) << 5); R = (st >> 1) * 16 + swz / 64; C = (st & 1) * 32 + (swz % 64) / 2; }
__host__ __device__ __forceinline__ int perm32(int rho) { const int n = rho >> 4, i = rho & 15; return 8 * (i >> 2) + 4 * n + (i & 3); }

struct Unit { int pm, pn; };
struct Gemm { const bf16_t* A; const bf16_t* Bt; int M, N, K; };

struct StaticOrder {
    int nM, nN, nwg, G, c;
    __host__ __device__ void init(int M, int N, int G_, int c_) { nM = M / BM; nN = N / BM; nwg = nM * nN; G = G_; c = c_; }
    __host__ __device__ bool next(int i, Unit& u) const {
        const long L = (long)i * G + c; if (L >= nwg) return false;
        int wgid = (int)L; { const int q = nwg / NXCD, r = nwg % NXCD, xcd = wgid % NXCD, off = wgid / NXCD; wgid = (xcd < r ? xcd * (q + 1) : r * (q + 1) + (xcd - r) * q) + off; }
        const int nig = WGM * nN, gid = wgid / nig, fm = gid * WGM, gsz = (nM - fm) < WGM ? (nM - fm) : WGM;
        u.pm = fm + ((wgid % nig) % gsz); u.pn = (wgid % nig) / gsz; return true;
    }
    __device__ __forceinline__ void a_ready(const Unit&) const {}
    __device__ __forceinline__ void done(const Unit&) const {}
};

__device__ __forceinline__ unsigned cvt_pk_bf16(float lo, float hi) { unsigned r; asm volatile("v_cvt_pk_bf16_f32 %0, %1, %2" : "=v"(r) : "v"(lo), "v"(hi)); return r; }
typedef float f32x2 __attribute__((ext_vector_type(2)));
typedef unsigned u32x2 __attribute__((ext_vector_type(2)));
constexpr float NORM_EPS_F = 1e-6f;
__device__ __forceinline__ float bf_lo(unsigned w) { return __uint_as_float(w << 16); }
__device__ __forceinline__ float bf_hi(unsigned w) { return __uint_as_float(w & 0xffff0000u); }
__device__ __forceinline__ u32x4 pack8(const f32x4 a, const f32x4 b) { u32x4 w; w.x = cvt_pk_bf16(a[0], a[1]); w.y = cvt_pk_bf16(a[2], a[3]); w.z = cvt_pk_bf16(b[0], b[1]); w.w = cvt_pk_bf16(b[2], b[3]); return w; }
__device__ __forceinline__ float sq8(const f32x4 a, const f32x4 b) { return (a[0] * a[0] + a[1] * a[1]) + (a[2] * a[2] + a[3] * a[3]) + (b[0] * b[0] + b[1] * b[1]) + (b[2] * b[2] + b[3] * b[3]); }
__device__ __forceinline__ float sigm(float v) { return __builtin_amdgcn_rcpf(1.0f + __expf(-v)); }

struct EpiProj {
    static constexpr bool PERM = true, AFTER_DRAIN = false, HAS_MIDK = false;
    bf16_t *CQ, *CKV, *DQ, *DK, *DV, *GA, *GB; float* KPER; const float* rstd0; float *ssq_q, *ssq_kv; const float* b_gate;
    __device__ __forceinline__ void operator()(const f32x4 (&acc)[2][2][4][2], const Unit& u, int wr, int wc, int fr, int fq) const {
        const int pn = u.pn; const int row0 = u.pm * BM + wr * 64 + fr; const int cw = wc * 32 + 8 * fq;
        bf16_t* base = CQ; int ldc = 512, c0 = 0; const float* bias = nullptr; float* ssq = nullptr;
        if (pn < 2) { base = CQ; ldc = 512; c0 = pn * 256; ssq = ssq_q; }
        else if (pn == 2) { base = CKV; ldc = 256; c0 = 0; ssq = ssq_kv; }
        else if (pn == 3) { base = nullptr; }
        else if (pn < 10) { base = DQ; ldc = 1536; c0 = (pn - 4) * 256; }
        else if (pn < 16) { base = DK; ldc = 1536; c0 = (pn - 10) * 256; }
        else if (pn < 22) { base = DV; ldc = 1536; c0 = (pn - 16) * 256; }
        else if (pn < 30) { base = GA; ldc = 2048; c0 = (pn - 22) * 256; bias = b_gate + c0; }
        else { base = GB; ldc = 2048; c0 = (pn - 30) * 256; bias = b_gate + 2048 + c0; }
        if (base == nullptr) {
            if (wc < 2) {
#pragma unroll
                for (int ai = 0; ai < 2; ++ai)
#pragma unroll
                    for (int m = 0; m < 4; ++m) { const int row = row0 + ai * HALF + m * 16; const float rs = rstd0[row];
                        float* p = KPER + (size_t)row * 64 + cw; *(f32x4*)p = acc[ai][0][m][0] * rs; *(f32x4*)(p + 4) = acc[ai][0][m][1] * rs; }
            }
            return;
        }
        f32x4 bv[2][2];
#pragma unroll
        for (int bj = 0; bj < 2; ++bj)
#pragma unroll
            for (int n = 0; n < 2; ++n) bv[bj][n] = bias ? *(const f32x4*)(bias + bj * HALF + cw + 4 * n) : (f32x4){0.f, 0.f, 0.f, 0.f};
#pragma unroll
        for (int ai = 0; ai < 2; ++ai)
#pragma unroll
            for (int m = 0; m < 4; ++m) { const int row = row0 + ai * HALF + m * 16; const float rs = rstd0[row]; bf16_t* rowp = base + (size_t)row * ldc + c0 + cw; float s = 0.f;
#pragma unroll
                for (int bj = 0; bj < 2; ++bj) { f32x4 v0 = acc[ai][bj][m][0] * rs, v1 = acc[ai][bj][m][1] * rs;
                    if (bias) { v0 = v0 + bv[bj][0]; v1 = v1 + bv[bj][1];
#pragma unroll
                        for (int e = 0; e < 4; ++e) { v0[e] = sigm(v0[e]); v1[e] = sigm(v1[e]); } }
                    s += sq8(v0, v1);
                    *(u32x4*)(rowp + bj * HALF) = pack8(v0, v1); }
                if (ssq) { s += __shfl_xor(s, 16); s += __shfl_xor(s, 32); if (fq == 0) atomicAdd(ssq + row, s); } }
    }
};

struct EpiRowScale {
    static constexpr bool PERM = true, AFTER_DRAIN = false, HAS_MIDK = false;
    bf16_t *O0, *O1; int split, ldc; const float* ssq; float inv_dim;
    __device__ __forceinline__ void operator()(const f32x4 (&acc)[2][2][4][2], const Unit& u, int wr, int wc, int fr, int fq) const {
        const int pn = u.pn; const int row0 = u.pm * BM + wr * 64 + fr; const int cw = wc * 32 + 8 * fq;
        bf16_t* base = pn < split ? O0 : O1; const int c0 = (pn < split ? pn : pn - split) * 256;
#pragma unroll
        for (int ai = 0; ai < 2; ++ai)
#pragma unroll
            for (int m = 0; m < 4; ++m) { const int row = row0 + ai * HALF + m * 16; const float rs = rsqrtf(ssq[row] * inv_dim + NORM_EPS_F); bf16_t* rowp = base + (size_t)row * ldc + c0 + cw;
#pragma unroll
                for (int bj = 0; bj < 2; ++bj) *(u32x4*)(rowp + bj * HALF) = pack8(acc[ai][bj][m][0] * rs, acc[ai][bj][m][1] * rs); }
    }
};

struct EpiGate {
    static constexpr bool PERM = true, AFTER_DRAIN = false, HAS_MIDK = false;
    const bf16_t* G; const float* addin; float* outf; bf16_t* outb;
    __device__ __forceinline__ void operator()(const f32x4 (&acc)[2][2][4][2], const Unit& u, int wr, int wc, int fr, int fq) const {
        const int row0 = u.pm * BM + wr * 64 + fr; const int col0 = u.pn * BM + wc * 32 + 8 * fq;
#pragma unroll
        for (int ai = 0; ai < 2; ++ai)
#pragma unroll
            for (int m = 0; m < 4; ++m) { const size_t off = (size_t)(row0 + ai * HALF + m * 16) * 2048 + col0;
#pragma unroll
                for (int bj = 0; bj < 2; ++bj) { const u32x4 g = *(const u32x4*)(G + off + bj * HALF);
                    f32x4 v0 = acc[ai][bj][m][0] * (f32x4){bf_lo(g.x), bf_hi(g.x), bf_lo(g.y), bf_hi(g.y)};
                    f32x4 v1 = acc[ai][bj][m][1] * (f32x4){bf_lo(g.z), bf_hi(g.z), bf_lo(g.w), bf_hi(g.w)};
                    if (addin) { v0 = v0 + *(const f32x4*)(addin + off + bj * HALF); v1 = v1 + *(const f32x4*)(addin + off + bj * HALF + 4); }
                    if (outf) { *(f32x4*)(outf + off + bj * HALF) = v0; *(f32x4*)(outf + off + bj * HALF + 4) = v1; }
                    if (outb) *(u32x4*)(outb + off + bj * HALF) = pack8(v0, v1); } }
    }
};

struct EpiResid {
    static constexpr bool PERM = true, AFTER_DRAIN = false, HAS_MIDK = false;
    const float* resid; float* outf; bf16_t* outb; float* ssq;
    __device__ __forceinline__ void operator()(const f32x4 (&acc)[2][2][4][2], const Unit& u, int wr, int wc, int fr, int fq) const {
        const int row0 = u.pm * BM + wr * 64 + fr; const int col0 = u.pn * BM + wc * 32 + 8 * fq;
#ifndef EPI_REP
#define EPI_REP 1
#endif
#pragma unroll 1
        for (int rp = 0; rp < 1; ++rp)
#pragma unroll
        for (int ai = 0; ai < 2; ++ai)
#pragma unroll
            for (int m = 0; m < 4; ++m) { const int row = row0 + ai * HALF + m * 16; const size_t off = (size_t)row * 2048 + col0; float s = 0.f;
#pragma unroll
                for (int bj = 0; bj < 2; ++bj) { const f32x4 v0 = acc[ai][bj][m][0] + *(const f32x4*)(resid + off + bj * HALF), v1 = acc[ai][bj][m][1] + *(const f32x4*)(resid + off + bj * HALF + 4);
                    s += sq8(v0, v1);
                    *(f32x4*)(outf + off + bj * HALF) = v0; *(f32x4*)(outf + off + bj * HALF + 4) = v1;
                    if (outb) *(u32x4*)(outb + off + bj * HALF) = pack8(v0, v1); }
                s += __shfl_xor(s, 16); s += __shfl_xor(s, 32); if (fq == 0 && rp == 0) atomicAdd(ssq + row, s); asm volatile("" ::: "memory"); }
    }
};


#define PG8_DPPV(NAME, CTRLSTR) __device__ __forceinline__ f32x4 NAME(f32x4 oldv, const f32x4 v) { \
    _Pragma("unroll") for (int e = 0; e < 4; ++e) { float o = oldv[e]; const float s_ = v[e]; \
        asm volatile("s_nop 1\n\tv_mov_b32_dpp %0, %1 " CTRLSTR " row_mask:0xf bank_mask:0xf" : "+v"(o) : "v"(s_)); oldv[e] = o; } \
    return oldv; }
PG8_DPPV(dpp_shr1, "row_shr:1")
PG8_DPPV(dpp_shr2, "row_shr:2")
PG8_DPPV(dpp_shl15, "row_shl:15")
PG8_DPPV(dpp_shl14, "row_shl:14")
__device__ __forceinline__ f32x4 prev1(const f32x4 xp, const f32x4 x) { const f32x4 z = (f32x4){0.f, 0.f, 0.f, 0.f}; return dpp_shr1(dpp_shl15(z, xp), x); }
__device__ __forceinline__ f32x4 prev2(const f32x4 xp, const f32x4 x) { const f32x4 z = (f32x4){0.f, 0.f, 0.f, 0.f}; return dpp_shr2(dpp_shl14(z, xp), x); }
struct EpiConvAct {
    static constexpr bool PERM = true, AFTER_DRAIN = false, HAS_MIDK = false;
    bf16_t* ACT; const float* ssq; const float* conv_w; const float* conv_b; float* HEAD; float* TAIL; PG8_LAS unsigned char* xch;
    static __device__ __forceinline__ int slot(int ai, int wr, int wc, int rr, int fq) { return ((((ai * 2 + wr) * 4 + wc) * 2 + rr) * 4 + fq) * 4; }
    __device__ __forceinline__ void operator()(const f32x4 (&acc)[2][2][4][2], const Unit& u, int wr, int wc, int fr, int fq) const {
        PG8_LAS f32x4* X = (PG8_LAS f32x4*)xch;
        const int row0 = u.pm * BM + wr * 64 + fr; const int cw = wc * 32 + 8 * fq; const int colt = u.pn * 256;
        float rs[2][4];
#pragma unroll
        for (int ai = 0; ai < 2; ++ai)
#pragma unroll
            for (int m = 0; m < 4; ++m) rs[ai][m] = rsqrtf(ssq[row0 + ai * HALF + m * 16] * (1.0f / 2048.0f) + NORM_EPS_F);
        if (fr >= 14) {
#pragma unroll
            for (int ai = 0; ai < 2; ++ai) { const int b = slot(ai, wr, wc, fr - 14, fq);
#pragma unroll
                for (int bj = 0; bj < 2; ++bj)
#pragma unroll
                    for (int n = 0; n < 2; ++n) { const f32x4 v = acc[ai][bj][3][n] * rs[ai][3]; X[b + bj * 2 + n] = v;
                        if (ai == 1 && wr == 1) *(f32x4*)(TAIL + (size_t)(u.pm * 2 + (fr - 14)) * 11008 + colt + bj * HALF + cw + 4 * n) = v; } }
        }
        if (fr < 2 && wr == 0) {
#pragma unroll
            for (int bj = 0; bj < 2; ++bj)
#pragma unroll
                for (int n = 0; n < 2; ++n) *(f32x4*)(HEAD + (size_t)(u.pm * 2 + fr) * 11008 + colt + bj * HALF + cw + 4 * n) = acc[0][bj][0][n] * rs[0][0];
        }
        asm volatile("s_waitcnt lgkmcnt(0)" ::: "memory"); __builtin_amdgcn_s_barrier(); asm volatile("" ::: "memory");
#pragma unroll
        for (int n = 0; n < 2; ++n) {
            const int c = u.pn * 128 + cw + 4 * n;
            f32x4 wu[3], wg[3];
#pragma unroll
            for (int k = 0; k < 3; ++k) { wu[k] = *(const f32x4*)(conv_w + (size_t)k * 11008 + c); wg[k] = *(const f32x4*)(conv_w + (size_t)k * 11008 + 5504 + c); }
            const f32x4 bu = *(const f32x4*)(conv_b + c), bg = *(const f32x4*)(conv_b + 5504 + c);
#pragma unroll
            for (int ai = 0; ai < 2; ++ai) {
                f32x4 pu = (f32x4){0.f, 0.f, 0.f, 0.f}, pg = pu;
                if (!(ai == 0 && wr == 0)) { const int b = slot(wr == 1 ? ai : ai - 1, wr ^ 1, wc, fr & 1, fq); pu = X[b + n]; pg = X[b + 2 + n]; }
#pragma unroll
                for (int m = 0; m < 4; ++m) {
                    const f32x4 xu = acc[ai][0][m][n] * rs[ai][m], xg = acc[ai][1][m][n] * rs[ai][m];
                    const f32x4 p1u = prev1(pu, xu), p2u = prev2(pu, xu), p1g = prev1(pg, xg), p2g = prev2(pg, xg);
                    const f32x4 cu = bu + wu[0] * p2u + wu[1] * p1u + wu[2] * xu, cgt = bg + wg[0] * p2g + wg[1] * p1g + wg[2] * xg;
                    float a[4];
#pragma unroll
                    for (int e = 0; e < 4; ++e) a[e] = cu[e] * cgt[e] * __builtin_amdgcn_rcpf(1.0f + __expf(-cgt[e]));
                    u32x2 w; w.x = cvt_pk_bf16(a[0], a[1]); w.y = cvt_pk_bf16(a[2], a[3]);
                    *(u32x2*)(ACT + (size_t)(row0 + ai * HALF + m * 16) * 5504 + c) = w;
                    pu = xu; pg = xg;
                }
            }
        }
    }
};

struct EpiMerge {
    static constexpr bool PERM = true, AFTER_DRAIN = false, HAS_MIDK = true;
    const bf16_t* GA; const bf16_t* GB; bf16_t* outb; int midk_t;
    __device__ __forceinline__ void midk(f32x4 (&acc)[2][2][4][2], const Unit& u, int wr, int wc, int fr, int fq) const {
        int row0 = u.pm * BM + wr * 64 + fr; const int col0 = u.pn * BM + wc * 32 + 8 * fq;
        asm volatile("" : "+v"(row0));
#pragma unroll
        for (int ai = 0; ai < 2; ++ai)
#pragma unroll
            for (int m = 0; m < 4; ++m) { const unsigned off = (unsigned)((row0 + ai * HALF + m * 16) * 2048 + col0);
#pragma unroll
                for (int bj = 0; bj < 2; ++bj) { const u32x4 a = *(const u32x4*)(GA + off + bj * HALF), b = *(const u32x4*)(GB + off + bj * HALF);
                    f32x4 r0, r1;
                    r0[0] = bf_lo(a.x) * __builtin_amdgcn_rcpf(fmaxf(bf_lo(b.x), 1e-20f)); r0[1] = bf_hi(a.x) * __builtin_amdgcn_rcpf(fmaxf(bf_hi(b.x), 1e-20f)); r0[2] = bf_lo(a.y) * __builtin_amdgcn_rcpf(fmaxf(bf_lo(b.y), 1e-20f)); r0[3] = bf_hi(a.y) * __builtin_amdgcn_rcpf(fmaxf(bf_hi(b.y), 1e-20f));
                    r1[0] = bf_lo(a.z) * __builtin_amdgcn_rcpf(fmaxf(bf_lo(b.z), 1e-20f)); r1[1] = bf_hi(a.z) * __builtin_amdgcn_rcpf(fmaxf(bf_hi(b.z), 1e-20f)); r1[2] = bf_lo(a.w) * __builtin_amdgcn_rcpf(fmaxf(bf_lo(b.w), 1e-20f)); r1[3] = bf_hi(a.w) * __builtin_amdgcn_rcpf(fmaxf(bf_hi(b.w), 1e-20f));
                    acc[ai][bj][m][0] = acc[ai][bj][m][0] * r0; acc[ai][bj][m][1] = acc[ai][bj][m][1] * r1; } }
    }
    __device__ __forceinline__ void operator()(const f32x4 (&acc)[2][2][4][2], const Unit& u, int wr, int wc, int fr, int fq) const {
        const int row0 = u.pm * BM + wr * 64 + fr; const int col0 = u.pn * BM + wc * 32 + 8 * fq;
#pragma unroll
        for (int ai = 0; ai < 2; ++ai)
#pragma unroll
            for (int m = 0; m < 4; ++m) { const size_t off = (size_t)(row0 + ai * HALF + m * 16) * 2048 + col0;
#pragma unroll
                for (int bj = 0; bj < 2; ++bj) { const u32x4 b = *(const u32x4*)(GB + off + bj * HALF);
                    const f32x4 g0 = (f32x4){fmaxf(bf_lo(b.x), 1e-20f), fmaxf(bf_hi(b.x), 1e-20f), fmaxf(bf_lo(b.y), 1e-20f), fmaxf(bf_hi(b.y), 1e-20f)};
                    const f32x4 g1 = (f32x4){fmaxf(bf_lo(b.z), 1e-20f), fmaxf(bf_hi(b.z), 1e-20f), fmaxf(bf_lo(b.w), 1e-20f), fmaxf(bf_hi(b.w), 1e-20f)};
                    *(u32x4*)(outb + off + bj * HALF) = pack8(acc[ai][bj][m][0] * g0, acc[ai][bj][m][1] * g1); } }
    }
};

struct EpiColScale {
    static constexpr bool PERM = true, AFTER_DRAIN = false, HAS_MIDK = false;
    bf16_t* O; int ldc; const float* ssq; float inv_dim;
    __device__ __forceinline__ void operator()(const f32x4 (&acc)[2][2][4][2], const Unit& u, int wr, int wc, int fr, int fq) const {
        int row0 = u.pm * BM + wr * 64 + fr; const int col0 = u.pn * BM + wc * 32 + 8 * fq;
        asm volatile("" : "+v"(row0));
#pragma unroll
        for (int bj = 0; bj < 2; ++bj)
#pragma unroll
            for (int n = 0; n < 2; ++n) {
                f32x4 c = *(const f32x4*)(ssq + col0 + bj * HALF + 4 * n);
#pragma unroll
                for (int e = 0; e < 4; ++e) c[e] = rsqrtf(c[e] * inv_dim + NORM_EPS_F);
#pragma unroll
                for (int ai = 0; ai < 2; ++ai)
#pragma unroll
                    for (int m = 0; m < 4; ++m) { const f32x4 v = acc[ai][bj][m][n] * c; u32x2 w; w.x = cvt_pk_bf16(v[0], v[1]); w.y = cvt_pk_bf16(v[2], v[3]);
                        *(u32x2*)(O + (size_t)(row0 + ai * HALF + m * 16) * ldc + col0 + bj * HALF + 4 * n) = w; }
            }
    }
};

struct RangeOrder {
    StaticOrder S; int i0, n;
    __host__ __device__ bool next(int i, Unit& u) const { return i < n && S.next(i0 + i, u); }
    __device__ __forceinline__ void a_ready(const Unit&) const {}
    __device__ __forceinline__ void done(const Unit&) const {}
};
template <class Epi, class Sched, bool ALIGN_EPI = false, bool SP2 = false>
__device__ __forceinline__ void gemm_phase(PG8_LAS unsigned char* lds, const Gemm g, const Sched& S, const Epi& E, const int tid_in) {
    int tid_ = tid_in; asm volatile("" : "+v"(tid_));
    const int tid = tid_, wid = __builtin_amdgcn_readfirstlane(tid >> 6), lane = tid & 63, wr = wid >> 2, wc = wid & 3, fr = lane & 15, fq = lane >> 4;
    const int K = g.K, nt = K / BK;
    unsigned voffA[2], voffB[2];
#pragma unroll
    for (int i = 0; i < 2; ++i) { int R, C; stage_rc(tid * 16 + i * 8192, R, C); const int Rb = Epi::PERM ? ((R & ~31) + perm32(R & 31)) : R;
        voffA[i] = (unsigned)(R * K + C) * 2u; voffB[i] = (unsigned)(Rb * K + C) * 2u; }
    const size_t kstep = (size_t)(BK * 2);
    const size_t hstep = (size_t)HALF * K * 2;
    const size_t tstep = 2 * hstep;
    const unsigned ldsw = (unsigned)wid * 1024u;
    const int aoff = lds_byte(wr * 64 + fr, fq * 8), boff = lds_byte(wc * 32 + fr, fq * 8);
#define PG8_SA(b, h) (((b) * 2 + (h)) * HTB)
#define PG8_SB(b, h) ((4 + (b) * 2 + (h)) * HTB)
#define PG8_STAGE(bufoff, gbase, voff) do { _Pragma("unroll") for (int _i = 0; _i < 2; ++_i) \
        __builtin_amdgcn_global_load_lds((const unsigned*)((const char*)(gbase) + (voff)[_i]), (PG8_LAS unsigned*)(lds + (bufoff) + ldsw + _i * 8192), 16, 0, 0); } while (0)
#define PG8_LDA(dst, b, h) do { _Pragma("unroll") for (int m = 0; m < 4; ++m) _Pragma("unroll") for (int k = 0; k < 2; ++k) dst[m][k] = *(const PG8_LAS bf16x8*)(lds + PG8_SA(b, h) + aoff + m * 2048 + k * 1024); } while (0)
#define PG8_LDB(dst, b, h) do { _Pragma("unroll") for (int n = 0; n < 2; ++n) _Pragma("unroll") for (int k = 0; k < 2; ++k) dst[n][k] = *(const PG8_LAS bf16x8*)(lds + PG8_SB(b, h) + boff + n * 2048 + k * 1024); } while (0)
#define PG8_MMA(ai, bj, At, Bt) do { __builtin_amdgcn_s_setprio(1); _Pragma("unroll") for (int m = 0; m < 4; ++m) _Pragma("unroll") for (int n = 0; n < 2; ++n) _Pragma("unroll") for (int k = 0; k < 2; ++k) \
        acc[ai][bj][m][n] = __builtin_amdgcn_mfma_f32_16x16x32_bf16(Bt[n][k], At[m][k], acc[ai][bj][m][n], 0, 0, 0); __builtin_amdgcn_s_setprio(0); } while (0)
#define PG8_WAIT_V(n) asm volatile("s_waitcnt vmcnt(" #n ")" ::: "memory")
#define PG8_WAIT_L(n) asm volatile("s_waitcnt lgkmcnt(" #n ")" ::: "memory")
#define PG8_BAR __builtin_amdgcn_s_barrier()
#define PG8_SCHED __builtin_amdgcn_sched_barrier(0)
    Unit cur, nxt; int ui = 0;
    if (!S.next(0, cur)) return;
    f32x4 acc[2][2][4][2];
#pragma unroll
    for (int a = 0; a < 2; ++a)
#pragma unroll
        for (int b = 0; b < 2; ++b)
#pragma unroll
            for (int m = 0; m < 4; ++m)
#pragma unroll
                for (int n = 0; n < 2; ++n) acc[a][b][m][n] = (f32x4){0.f, 0.f, 0.f, 0.f};
    bf16x8 At[4][2], B0[2][2], B1[2][2];
    const char* cA = (const char*)g.A + (size_t)cur.pm * tstep; const char* cB = (const char*)g.Bt + (size_t)cur.pn * tstep;
    S.a_ready(cur);
    if constexpr (SP2) {
        PG8_STAGE(PG8_SB(0, 0), cB, voffB); PG8_STAGE(PG8_SB(0, 1), cB + hstep, voffB); PG8_STAGE(PG8_SA(0, 0), cA, voffA); PG8_STAGE(PG8_SA(0, 1), cA + hstep, voffA);
        if (wr == 1) PG8_BAR;
        PG8_WAIT_V(2); PG8_BAR;
        PG8_STAGE(PG8_SB(1, 0), cB + kstep, voffB); PG8_STAGE(PG8_SA(1, 0), cA + kstep, voffA); PG8_STAGE(PG8_SB(1, 1), cB + hstep + kstep, voffB);
        PG8_WAIT_V(6); PG8_BAR;
    } else {
        PG8_STAGE(PG8_SB(0, 0), cB, voffB); PG8_STAGE(PG8_SA(0, 0), cA, voffA); PG8_STAGE(PG8_SB(0, 1), cB + hstep, voffB); PG8_STAGE(PG8_SA(0, 1), cA + hstep, voffA);
        if (wr == 1) PG8_BAR;
        PG8_WAIT_V(4); PG8_BAR;
        PG8_STAGE(PG8_SB(1, 0), cB + kstep, voffB); PG8_STAGE(PG8_SA(1, 0), cA + kstep, voffA); PG8_STAGE(PG8_SB(1, 1), cB + hstep + kstep, voffB);
        PG8_WAIT_V(6); PG8_BAR;
    }
    for (;;) {
        const bool has_next = S.next(ui + 1, nxt);
        const char* nA = has_next ? (const char*)g.A + (size_t)nxt.pm * tstep : cA; const char* nB = has_next ? (const char*)g.Bt + (size_t)nxt.pn * tstep : cB;
        for (int t = 0; t < nt; t += 2) {
            if constexpr (Epi::HAS_MIDK) { if (t == E.midk_t) E.midk(acc, cur, wr, wc, fr, fq); }
            const bool last = (t == nt - 2);
            const char* a1 = cA + (size_t)(t + 1) * kstep;
            const char* a2 = last ? nA : cA + (size_t)(t + 2) * kstep; const char* b2 = last ? nB : cB + (size_t)(t + 2) * kstep;
            const char* a3 = a2 + kstep; const char* b3 = b2 + kstep;
            if (last && has_next) S.a_ready(nxt);
            if constexpr (SP2) {
            PG8_LDB(B0, 0, 0); PG8_LDB(B1, 0, 1); PG8_SCHED; PG8_LDA(At, 0, 0); PG8_STAGE(PG8_SA(1, 1), a1 + hstep, voffA);
            PG8_WAIT_V(8); PG8_WAIT_L(0); PG8_BAR; PG8_MMA(0, 0, At, B0); PG8_MMA(0, 1, At, B1); PG8_BAR; PG8_SCHED;
            PG8_LDA(At, 0, 1); PG8_STAGE(PG8_SB(0, 0), b2, voffB); PG8_STAGE(PG8_SB(0, 1), b2 + hstep, voffB); PG8_STAGE(PG8_SA(0, 0), a2, voffA);
            PG8_WAIT_V(8); PG8_WAIT_L(0); PG8_BAR; PG8_MMA(1, 0, At, B0); PG8_MMA(1, 1, At, B1); PG8_BAR; PG8_SCHED;
            PG8_LDB(B0, 1, 0); PG8_LDB(B1, 1, 1); PG8_SCHED; PG8_LDA(At, 1, 0); PG8_STAGE(PG8_SA(0, 1), a2 + hstep, voffA);
            PG8_WAIT_V(8); PG8_WAIT_L(0); PG8_BAR; PG8_MMA(0, 0, At, B0); PG8_MMA(0, 1, At, B1); PG8_BAR; PG8_SCHED;
            PG8_LDA(At, 1, 1); PG8_STAGE(PG8_SB(1, 0), b3, voffB); PG8_STAGE(PG8_SB(1, 1), b3 + hstep, voffB); PG8_STAGE(PG8_SA(1, 0), a3, voffA);
            PG8_WAIT_V(8); PG8_WAIT_L(0); PG8_BAR; PG8_MMA(1, 0, At, B0); PG8_MMA(1, 1, At, B1); PG8_BAR; PG8_SCHED;
            } else {
            PG8_LDB(B0, 0, 0); PG8_SCHED; PG8_LDA(At, 0, 0); PG8_STAGE(PG8_SA(1, 1), a1 + hstep, voffA);
            PG8_WAIT_L(8); PG8_BAR; PG8_WAIT_L(0); PG8_MMA(0, 0, At, B0); PG8_BAR; PG8_SCHED;
            PG8_LDB(B1, 0, 1); PG8_STAGE(PG8_SB(0, 0), b2, voffB);
            PG8_BAR; PG8_WAIT_L(0); PG8_MMA(0, 1, At, B1); PG8_BAR;
            PG8_LDA(At, 0, 1); PG8_STAGE(PG8_SA(0, 0), a2, voffA);
            PG8_BAR; PG8_WAIT_L(0); PG8_MMA(1, 0, At, B0); PG8_BAR; PG8_SCHED;
            PG8_STAGE(PG8_SB(0, 1), b2 + hstep, voffB);
            PG8_WAIT_V(6); PG8_BAR; PG8_MMA(1, 1, At, B1); PG8_BAR;
            PG8_LDB(B0, 1, 0); PG8_SCHED; PG8_LDA(At, 1, 0); PG8_STAGE(PG8_SA(0, 1), a2 + hstep, voffA);
            PG8_WAIT_L(8); PG8_BAR; PG8_WAIT_L(0); PG8_MMA(0, 0, At, B0); PG8_BAR; PG8_SCHED;
            PG8_LDB(B1, 1, 1); PG8_STAGE(PG8_SB(1, 0), b3, voffB);
            PG8_BAR; PG8_WAIT_L(0); PG8_MMA(0, 1, At, B1); PG8_BAR;
            PG8_LDA(At, 1, 1); PG8_STAGE(PG8_SA(1, 0), a3, voffA);
            PG8_BAR; PG8_WAIT_L(0); PG8_MMA(1, 0, At, B0); PG8_BAR; PG8_SCHED;
            PG8_STAGE(PG8_SB(1, 1), b3 + hstep, voffB);
            PG8_WAIT_V(6); PG8_BAR; PG8_MMA(1, 1, At, B1); PG8_BAR;
            }
        }
        if constexpr (ALIGN_EPI) { if (wr == 0) PG8_BAR; }
        if constexpr (!Epi::AFTER_DRAIN) { E(acc, cur, wr, wc, fr, fq); S.done(cur); }
        if (!has_next) break;
#pragma unroll
        for (int a = 0; a < 2; ++a)
#pragma unroll
            for (int b = 0; b < 2; ++b)
#pragma unroll
                for (int m = 0; m < 4; ++m)
#pragma unroll
                    for (int n = 0; n < 2; ++n) acc[a][b][m][n] = (f32x4){0.f, 0.f, 0.f, 0.f};
        cur = nxt; cA = nA; cB = nB; ++ui;
        if constexpr (ALIGN_EPI) { if (wr == 1) PG8_BAR; }
    }
    PG8_WAIT_V(0);
    if constexpr (!ALIGN_EPI) { if (wr == 0) PG8_BAR; }
    PG8_BAR;
    if constexpr (Epi::AFTER_DRAIN) { E.fused(acc, cur, wr, wc, fr, fq, lds, wid, lane); S.done(cur); }
#undef PG8_SA
#undef PG8_SB
#undef PG8_STAGE
#undef PG8_LDA
#undef PG8_LDB
#undef PG8_MMA
#undef PG8_WAIT_V
#undef PG8_WAIT_L
#undef PG8_BAR
#undef PG8_SCHED
}
}
#define LAS __attribute__((address_space(3)))
typedef unsigned short bf16;
typedef float f32x4 __attribute__((ext_vector_type(4)));
typedef float f32x2v __attribute__((ext_vector_type(2)));
typedef float f32x16 __attribute__((ext_vector_type(16)));
typedef unsigned v4u __attribute__((ext_vector_type(4)));
typedef unsigned v2u __attribute__((ext_vector_type(2)));
typedef short bf16x8 __attribute__((ext_vector_type(8)));
using pg8::cvt_pk_bf16;
__device__ __forceinline__ float bflo(unsigned w) { return __uint_as_float(w << 16); }
__device__ __forceinline__ float bfhi(unsigned w) { return __uint_as_float(w & 0xffff0000u); }
__device__ __forceinline__ float wave_sum(float v) {
#pragma unroll
    for (int o = 1; o < 64; o <<= 1) v += __shfl_xor(v, o);
    return v;
}

constexpr int VT_STR = 144;
template <int DQK, bool ROPEQ, bool VTR>
__device__ __forceinline__ void attn_unit(LAS unsigned char* lds,
        const bf16* Qb, long q_pitch, const bf16* Kb, long k_pitch, const bf16* Kpe, long kpe_pitch, const bf16* Vb, long v_pitch,
        bf16* Ob, long o_pitch, float* lse, long lse_pitch, int q0, int W, float sc2, float slope2, const f32x2v* rope, const int tid_in) {
    constexpr int KSTR = DQK * 2 + 16;
    constexpr int ND0 = DQK / 16;
    LAS unsigned char* Kt = lds;
    LAS unsigned char* Vt = lds + 64 * KSTR;
    int tid_ = tid_in; asm volatile("" : "+v"(tid_));
    const int tid = tid_, lane = tid & 63, r32 = lane & 31, hi = lane >> 5; const int wid = __builtin_amdgcn_readfirstlane(tid >> 6);
    const int qlo = q0 + 32 * wid, qrow = qlo + r32;
    bf16x8 qf[ND0];
    { const bf16* qp = Qb + (long)qrow * q_pitch + 8 * hi;
#pragma unroll
      for (int d0 = 0; d0 < ND0; ++d0) qf[d0] = *(const bf16x8*)(qp + 16 * d0); }
    if constexpr (ROPEQ) {
#pragma unroll
        for (int dp = 0; dp < 2; ++dp) {
            const f32x2v* rp = rope + (long)qrow * 32 + 16 * dp + 8 * hi;
            bf16x8 x1 = qf[8 + dp], x2 = qf[10 + dp]; bf16x8 y1, y2;
#pragma unroll
            for (int j = 0; j < 8; j += 2) {
                const f32x2v cs0 = rp[j], cs1 = rp[j + 1];
                const float a0 = __uint_as_float(((unsigned)(unsigned short)x1[j]) << 16), a1 = __uint_as_float(((unsigned)(unsigned short)x1[j + 1]) << 16);
                const float b0 = __uint_as_float(((unsigned)(unsigned short)x2[j]) << 16), b1 = __uint_as_float(((unsigned)(unsigned short)x2[j + 1]) << 16);
                const unsigned w1 = cvt_pk_bf16(a0 * cs0.x - b0 * cs0.y, a1 * cs1.x - b1 * cs1.y);
                const unsigned w2 = cvt_pk_bf16(b0 * cs0.x + a0 * cs0.y, b1 * cs1.x + a1 * cs1.y);
                y1[j] = (short)(w1 & 0xffffu); y1[j + 1] = (short)(w1 >> 16); y2[j] = (short)(w2 & 0xffffu); y2[j + 1] = (short)(w2 >> 16);
            }
            qf[8 + dp] = y1; qf[10 + dp] = y2;
        }
    }
    f32x16 o[4];
#pragma unroll
    for (int i = 0; i < 4; ++i) o[i] = f32x16{};
    float m_run = -1e30f, l_run = 0.f;
    const int kt_hi = (q0 >> 6) + 3; int kt_lo = (q0 - W) >> 6; if (kt_lo < 0) kt_lo = 0;
    const int kr0 = tid >> 4, kc0 = tid & 15;
    const int pr = tid >> 3, pc = tid & 7;
    const int vc0 = wid, vc1 = wid + 8;
    v4u kreg0, kreg1, preg = (v4u){0u, 0u, 0u, 0u}, vreg0, vreg1;
    const unsigned koff0 = (unsigned)((kr0 * k_pitch + 8 * kc0) * 2), koff1 = (unsigned)(((kr0 + 32) * k_pitch + 8 * kc0) * 2), poff = (unsigned)((pr * kpe_pitch + 8 * pc) * 2);
    const unsigned voff0 = VTR ? (unsigned)(((tid >> 3) * v_pitch + (tid & 7) * 8) * 2) : (unsigned)((lane * v_pitch + 8 * vc0) * 2), voff1 = VTR ? voff0 + (unsigned)(64 * v_pitch * 2) : voff0 + 128u;
#define ATT_LOAD(kt) do { const char* kb_ = (const char*)Kb + (size_t)(kt) * 128 * (size_t)k_pitch; const char* vb_ = (const char*)Vb + (VTR ? (size_t)(kt) * 128 : (size_t)(kt) * 128 * (size_t)v_pitch); \
        kreg0 = *(const v4u*)(kb_ + koff0); kreg1 = *(const v4u*)(kb_ + koff1); \
        if constexpr (DQK == 192) { const char* pb_ = (const char*)Kpe + (size_t)(kt) * 128 * (size_t)kpe_pitch; preg = *(const v4u*)(pb_ + poff); } \
        vreg0 = *(const v4u*)(vb_ + voff0); vreg1 = *(const v4u*)(vb_ + voff1); } while (0)
    constexpr int TILE_BYTES = 64 * KSTR + 128 * VT_STR;
    const int pir = (r32 & ~12) | ((r32 & 4) << 1) | ((r32 & 8) >> 1);
    const LAS unsigned char* kread0 = Kt + pir * KSTR + hi * 16;
    const LAS unsigned char* vread0 = Vt + r32 * VT_STR + hi * 16;
#define ATT_STAGE(boff) do { LAS unsigned char* kt_ = Kt + (boff); LAS unsigned char* vt_ = Vt + (boff); \
        *(LAS v4u*)(kt_ + kr0 * KSTR + kc0 * 16) = kreg0; *(LAS v4u*)(kt_ + (kr0 + 32) * KSTR + kc0 * 16) = kreg1; \
        if constexpr (DQK == 192) *(LAS v4u*)(kt_ + pr * KSTR + 256 + pc * 16) = preg; \
        if constexpr (VTR) { *(LAS v4u*)(vt_ + (tid >> 3) * VT_STR + (tid & 7) * 16) = vreg0; *(LAS v4u*)(vt_ + ((tid >> 3) + 64) * VT_STR + (tid & 7) * 16) = vreg1; } \
        else { LAS unsigned short* v0p = (LAS unsigned short*)(vt_ + (8 * vc0) * VT_STR + lane * 2); LAS unsigned short* v1p = (LAS unsigned short*)(vt_ + (8 * vc1) * VT_STR + lane * 2); \
            _Pragma("unroll") for (int j = 0; j < 4; ++j) { \
                v0p[(2 * j) * (VT_STR / 2)] = (unsigned short)(vreg0[j] & 0xffffu); v0p[(2 * j + 1) * (VT_STR / 2)] = (unsigned short)(vreg0[j] >> 16); \
                v1p[(2 * j) * (VT_STR / 2)] = (unsigned short)(vreg1[j] & 0xffffu); v1p[(2 * j + 1) * (VT_STR / 2)] = (unsigned short)(vreg1[j] >> 16); } } } while (0)
    ATT_LOAD(kt_lo);
    __syncthreads();
    ATT_STAGE(0);
    if (kt_lo < kt_hi) ATT_LOAD(kt_lo + 1);
    __syncthreads();
#pragma unroll 1
    for (int kt = kt_lo; kt <= kt_hi; ++kt) {
        const int boff = ((kt - kt_lo) & 1) * TILE_BYTES;
        const LAS unsigned char* kread = kread0 + boff; const LAS unsigned char* vread = vread0 + boff;
        const int k0 = kt * 64;
        if (!(k0 > qlo + 31 || k0 + 63 < qlo - W)) {
        f32x16 p0 = f32x16{}, p1 = f32x16{};
#pragma unroll
        for (int d0 = 0; d0 < ND0; ++d0) {
            const bf16x8 a0 = *(const LAS bf16x8*)(kread + d0 * 32), a1 = *(const LAS bf16x8*)(kread + 32 * KSTR + d0 * 32);
            p0 = __builtin_amdgcn_mfma_f32_32x32x16_bf16(a0, qf[d0], p0, 0, 0, 0);
            p1 = __builtin_amdgcn_mfma_f32_32x32x16_bf16(a1, qf[d0], p1, 0, 0, 0);
        }
        const bool need_mask = (k0 + 63 > qlo) || (k0 < qlo + 31 - W);
        const int dbase = qrow - k0 - 8 * hi;
        float mx = -INFINITY;
        if (slope2 != 0.f) {
            const float sr = slope2 / sc2, b0 = -sr * (float)dbase;
#pragma unroll
            for (int r = 0; r < 16; ++r) { const float c = (float)(16 * (r >> 3) + (r & 7)); p0[r] += __builtin_fmaf(sr, c, b0); p1[r] += __builtin_fmaf(sr, c + 32.0f, b0); }
        }
        if (need_mask) {
#pragma unroll
            for (int r = 0; r < 16; ++r) { const int c = 16 * (r >> 3) + (r & 7);
                if ((unsigned)(dbase - c) > (unsigned)W) p0[r] = -INFINITY;
                if ((unsigned)(dbase - c - 32) > (unsigned)W) p1[r] = -INFINITY; }
        }
#pragma unroll
        for (int r = 0; r < 16; r += 2) mx = fmaxf(mx, fmaxf(fmaxf(p0[r], p0[r + 1]), fmaxf(p1[r], p1[r + 1])));
        mx = fmaxf(mx, __shfl_xor(mx, 32)) * sc2;
        const float m_new = fmaxf(m_run, mx), alpha = __builtin_amdgcn_exp2f(m_run - m_new);
        m_run = m_new;
        float rs = 0.f;
#pragma unroll
        for (int r = 0; r < 16; ++r) { p0[r] = __builtin_amdgcn_exp2f(__builtin_fmaf(p0[r], sc2, -m_new)); p1[r] = __builtin_amdgcn_exp2f(__builtin_fmaf(p1[r], sc2, -m_new)); rs += p0[r] + p1[r]; }
        l_run = l_run * alpha + rs;
#pragma unroll
        for (int i = 0; i < 4; ++i)
#pragma unroll
            for (int r = 0; r < 16; ++r) o[i][r] *= alpha;
        bf16x8 pf[4];
#pragma unroll
        for (int s = 0; s < 2; ++s) {
            v4u w0, w1;
            w0.x = cvt_pk_bf16(p0[8 * s + 0], p0[8 * s + 1]); w0.y = cvt_pk_bf16(p0[8 * s + 2], p0[8 * s + 3]); w0.z = cvt_pk_bf16(p0[8 * s + 4], p0[8 * s + 5]); w0.w = cvt_pk_bf16(p0[8 * s + 6], p0[8 * s + 7]);
            w1.x = cvt_pk_bf16(p1[8 * s + 0], p1[8 * s + 1]); w1.y = cvt_pk_bf16(p1[8 * s + 2], p1[8 * s + 3]); w1.z = cvt_pk_bf16(p1[8 * s + 4], p1[8 * s + 5]); w1.w = cvt_pk_bf16(p1[8 * s + 6], p1[8 * s + 7]);
            pf[s] = __builtin_bit_cast(bf16x8, w0); pf[2 + s] = __builtin_bit_cast(bf16x8, w1);
        }
#pragma unroll
        for (int db = 0; db < 4; ++db)
#pragma unroll
            for (int s = 0; s < 4; ++s) {
                const bf16x8 vf = *(const LAS bf16x8*)(vread + db * 32 * VT_STR + s * 32);
                o[db] = __builtin_amdgcn_mfma_f32_32x32x16_bf16(vf, pf[s], o[db], 0, 0, 0);
            }
        }
        if (kt < kt_hi) { ATT_STAGE(TILE_BYTES - boff); if (kt + 1 < kt_hi) ATT_LOAD(kt + 2); }
        __syncthreads();
    }
#undef ATT_LOAD
#undef ATT_STAGE
    const float l_tot = l_run + __shfl_xor(l_run, 32), inv = 1.0f / l_tot;
    bf16* op = Ob + (long)qrow * o_pitch + 4 * hi;
#pragma unroll
    for (int db = 0; db < 4; ++db)
#pragma unroll
        for (int g = 0; g < 4; ++g) { v2u w; w.x = cvt_pk_bf16(o[db][4 * g] * inv, o[db][4 * g + 1] * inv); w.y = cvt_pk_bf16(o[db][4 * g + 2] * inv, o[db][4 * g + 3] * inv);
            *(v2u*)(op + 32 * db + 8 * g) = w; }
    if (lse != nullptr && hi == 0) lse[(long)qrow * lse_pitch] = (m_run + __builtin_amdgcn_logf(l_tot)) * 0.6931471805599453f;
}
constexpr int T = 16384, SEQ = 4096, DM = 2048, DFF = 5504, NUP = 2 * DFF;
constexpr int N_IN_PAD = 9728;
constexpr int UP_TILES_A = 24, UP_TILES_B = 19;
constexpr size_t MiB = 1u << 20;
constexpr size_t WS_RSTD0 = 0, WS_SSQQ = 65536, WS_SSQKV = 2 * 65536, WS_SSQ1 = 3 * 65536, WS_SSQ2 = 4 * 65536;
constexpr size_t WS_LSE = 1 * MiB;
constexpr size_t WS_ROPE = 2 * MiB;
constexpr size_t WS_WUQ = 3 * MiB;
constexpr size_t WS_WKV = WS_WUQ + 1536 * 512 * 2;
constexpr size_t WS_WOM = WS_WKV + 2048 * 256 * 2;
constexpr size_t WS_WOD = WS_WOM + 2048 * 1024 * 2;
constexpr size_t WS_WOUT = WS_WOD + 2048 * 512 * 2;
constexpr size_t WS_A = 19 * MiB + 512 * 1024;
constexpr size_t WS_C = 83 * MiB + 512 * 1024;
constexpr size_t WS_WIN = WS_C, WS_V = WS_C;
constexpr size_t WS_CQ = 122 * MiB, WS_CKV = 138 * MiB, WS_KPER = 146 * MiB;
constexpr size_t WS_WDN = WS_C, WS_WUP = WS_WDN + (size_t)DM * DFF * 2;
constexpr size_t WS_E = 150 * MiB;
constexpr size_t WS_DQ = WS_E, WS_DK = WS_E + 48 * MiB, WS_DV = WS_E + 96 * MiB;
constexpr size_t WS_ATT = WS_E, WS_DIL = WS_E + 32 * MiB;
constexpr size_t WS_GA = 294 * MiB, WS_GB = 358 * MiB;
constexpr size_t WS_G = 422 * MiB;
constexpr size_t WS_Q = WS_G, WS_KN = WS_G + 48 * MiB, WS_KPE = WS_G + 80 * MiB, WS_MERGEB = WS_G;
constexpr size_t WS_U = 148 * MiB;
constexpr size_t WS_ACT = 340 * MiB;
constexpr size_t WS_END = 512 * MiB;
static_assert(WS_WOUT + (size_t)DM * DM * 2 <= WS_A && WS_A + 64 * MiB <= WS_C && WS_C + 38 * MiB <= WS_CQ, "small weights / A / C");
static_assert(WS_WUP + (size_t)NUP * DM * 2 <= WS_U, "wup");
static_assert((size_t)T * UP_TILES_A * 256 * 2 == 192 * MiB, "U");
constexpr size_t WS_ACT_REAL = WS_U + 192 * MiB;
static_assert(WS_ACT_REAL + (size_t)T * DFF * 2 <= WS_END, "ACT must fit");

struct Args { const float* in[17]; float* out; unsigned char* ws; int ph_lo, ph_hi, coop, pad; };

__device__ __forceinline__ int map_row(int code, int n) {
    switch (code) {
        case 1: return n < 832 ? n : n + 192;
        case 2: { const int h = n >> 8, j = n & 255; return j < 128 ? h * 128 + j : 1024 + h * 128 + (j - 128); }
        case 3: { const int gate = n >= DFF ? 1 : 0, c = n - gate * DFF; return (c >> 7) * 256 + gate * 128 + (c & 127); }
        default: return n;
    }
}
__device__ __forceinline__ void conv_item(const float* W, int K, int N, bf16* WT, int ldk, int kofs, const float* g, int code, LAS float* scr, int item, int lane) {
    const int nblk = N / 32, kb = item / nblk, nb = item % nblk, k0 = 64 * kb, n0 = 32 * nb;
    const int drow0 = map_row(code, n0);
    const int c = lane & 7;
    f32x4 g0 = (f32x4){1.f, 1.f, 1.f, 1.f}, g1 = g0;
    if (g) { g0 = *(const f32x4*)(g + k0 + 8 * c); g1 = *(const f32x4*)(g + k0 + 8 * c + 4); }
    { float wv[32]; const float* wp = W + (size_t)(k0 + (lane >> 5)) * N + n0 + (lane & 31);
#pragma unroll
      for (int i = 0; i < 32; ++i) wv[i] = wp[(size_t)(2 * i) * N];
#pragma unroll
      for (int i = 0; i < 32; ++i) { const int kk = 2 * i + (lane >> 5); scr[kk * 33 + (lane & 31)] = wv[i]; } }
    asm volatile("s_waitcnt lgkmcnt(0)" ::: "memory");
#pragma unroll
    for (int j = 0; j < 4; ++j) { const int n = (lane >> 3) + 8 * j; const LAS float* s = scr + (8 * c) * 33 + n;
        v4u o; o.x = cvt_pk_bf16(s[0 * 33] * g0[0], s[1 * 33] * g0[1]); o.y = cvt_pk_bf16(s[2 * 33] * g0[2], s[3 * 33] * g0[3]); o.z = cvt_pk_bf16(s[4 * 33] * g1[0], s[5 * 33] * g1[1]); o.w = cvt_pk_bf16(s[6 * 33] * g1[2], s[7 * 33] * g1[3]);
        *(v4u*)(WT + (size_t)(drow0 + n) * ldk + kofs + k0 + 8 * c) = o; }
    asm volatile("s_waitcnt lgkmcnt(0)" ::: "memory");
}
__device__ __forceinline__ void conv_matrix(const float* W, int K, int N, bf16* WT, int ldk, int kofs, const float* g, int code, LAS float* scr, int gw, int NGW, int lane) {
    const int nitems = (K / 64) * (N / 32);
    for (int it = gw; it < nitems; it += NGW) conv_item(W, K, N, WT, ldk, kofs, g, code, scr, it, lane);
}
__device__ __forceinline__ void conv_matrix_wg(const float* W, int K, int N, bf16* WT, int ldk, int kofs, const float* g, int code, LAS unsigned char* lds, int bid, int G, int tid, int& rot) {
    const int nblk = (N + 255) / 256, nitems = (K / 64) * nblk;
    const int lane = tid & 63, w = tid >> 6, c = tid & 7;
    int first = bid - rot; if (first < 0) first += G;
    for (int it = first; it < nitems; it += 2 * G) {
        const int it2 = it + G; const bool two = it2 < nitems;
        float v[2][32]; int k0s[2], n0s[2];
#pragma unroll
        for (int q = 0; q < 2; ++q) {
            const int iq = q == 0 ? it : (two ? it2 : it);
            const int kb = iq / nblk, nb = iq - kb * nblk; k0s[q] = 64 * kb; n0s[q] = 256 * nb;
            const float* wp = W + (size_t)(k0s[q] + 8 * w) * N + n0s[q] + lane;
            if (q == 0 || two) {
#pragma unroll
                for (int i = 0; i < 8; ++i)
#pragma unroll
                    for (int e = 0; e < 4; ++e) v[q][i * 4 + e] = (n0s[q] + lane + 64 * e < N) ? wp[(size_t)i * N + 64 * e] : 0.f;
            }
        }
        __syncthreads();
#pragma unroll
        for (int q = 0; q < 2; ++q) { LAS float* Tt = (LAS float*)lds + q * (64 * 257);
            if (q == 0 || two) {
#pragma unroll
                for (int i = 0; i < 8; ++i)
#pragma unroll
                    for (int e = 0; e < 4; ++e) Tt[(8 * w + i) * 257 + lane + 64 * e] = v[q][i * 4 + e];
            } }
        __syncthreads();
#pragma unroll
        for (int q = 0; q < 2; ++q) { const LAS float* Tt = (const LAS float*)lds + q * (64 * 257);
            if (q == 0 || two) {
                const int k0 = k0s[q], n0 = n0s[q];
                f32x4 g0 = (f32x4){1.f, 1.f, 1.f, 1.f}, g1 = g0;
                if (g) { g0 = *(const f32x4*)(g + k0 + 8 * c); g1 = *(const f32x4*)(g + k0 + 8 * c + 4); }
#pragma unroll
                for (int j = 0; j < 4; ++j) { const int n = (tid >> 3) + 64 * j;
                    if (n0 + n < N) { const LAS float* s = Tt + (8 * c) * 257 + n; const int drow = map_row(code, n0 + n);
                        v4u o; o.x = cvt_pk_bf16(s[0 * 257] * g0[0], s[1 * 257] * g0[1]); o.y = cvt_pk_bf16(s[2 * 257] * g0[2], s[3 * 257] * g0[3]); o.z = cvt_pk_bf16(s[4 * 257] * g1[0], s[5 * 257] * g1[1]); o.w = cvt_pk_bf16(s[6 * 257] * g1[2], s[7 * 257] * g1[3]);
                        *(v4u*)(WT + (size_t)drow * ldk + kofs + k0 + 8 * c) = o; } }
            } }
    }
    rot = (rot + nitems) % G;
    __syncthreads();
}
__device__ __forceinline__ void row_to_bf16_rstd(const float* xrow, bf16* orow, float* rstd_out, int lane) {
    const f32x4* xr = (const f32x4*)xrow + lane; f32x4 v[8]; float s = 0.f;
#pragma unroll
    for (int j = 0; j < 8; ++j) { v[j] = xr[64 * j]; s += (v[j].x * v[j].x + v[j].y * v[j].y) + (v[j].z * v[j].z + v[j].w * v[j].w); }
    s = wave_sum(s);
    if (lane == 0) *rstd_out = rsqrtf(s * (1.0f / DM) + 1e-6f);
    v2u* o8 = (v2u*)orow + lane;
#pragma unroll
    for (int j = 0; j < 8; ++j) { v2u w; w.x = cvt_pk_bf16(v[j].x, v[j].y); w.y = cvt_pk_bf16(v[j].z, v[j].w); o8[64 * j] = w; }
}

#define XB_TMO      128
#define XB_XCNT(j)  (256  + 64 * (j))
#define XB_XSUB(j)  (1280 + 64 * (j))
#define XB_XGEN(j)  (2304 + 64 * (j))
#define XB_TOP      3328
#define XB_TOPGEN   3392
#define XCD_BAR_WORDS 3456
#define XB_SPIN_CAP (1u << 20)
__device__ __forceinline__ unsigned xb_ld(unsigned* p)              { return __hip_atomic_load(p, __ATOMIC_RELAXED, __HIP_MEMORY_SCOPE_AGENT); }
__device__ __forceinline__ unsigned xb_add(unsigned* p, unsigned v) { return __hip_atomic_fetch_add(p, v, __ATOMIC_RELAXED, __HIP_MEMORY_SCOPE_AGENT); }
__device__ __forceinline__ unsigned xb_xcc_id() { return (unsigned)__builtin_amdgcn_s_getreg((3 << 11) | 20) & 0xFu; }
#define XB_SPIN(cond, bar) do { unsigned _sp = 0; while (cond) { __builtin_amdgcn_s_sleep(1); \
    if ((++_sp & 255u) == 0u) { if (xb_ld(&(bar)[XB_TMO])) break; if (_sp > XB_SPIN_CAP) { atomicAdd(&(bar)[XB_TMO], 1u); break; } } } } while (0)
__device__ __forceinline__ void xcd_barrier_complete(unsigned* bar, unsigned x, unsigned G, unsigned& nloc, unsigned& nx) {
    unsigned sum, cnt, mine, sp = 0u;
    for (;;) {
        sum = 0u; cnt = 0u; mine = 0u;
#pragma unroll
        for (unsigned j = 0; j < 16; ++j) { const unsigned c = xb_ld(&bar[XB_XCNT(j)]); sum += c; cnt += (c > 0u) ? 1u : 0u; mine = (j == x) ? c : mine; }
        if (sum == G) break;
        __builtin_amdgcn_s_sleep(1);
        if ((++sp & 255u) == 0u) { if (xb_ld(&bar[XB_TMO])) break; if (sp > XB_SPIN_CAP) { atomicAdd(&bar[XB_TMO], 1u); break; } }
    }
    nloc = mine > 0u ? mine : 1u; nx = cnt > 0u ? cnt : 1u;
}
__device__ __forceinline__ void xcd_barrier(unsigned* bar, volatile LAS unsigned* st, unsigned G, bool leader) {
    asm volatile("s_waitcnt vmcnt(0)" ::: "memory");
    __syncthreads();
    if (leader) {
        const unsigned x = xb_xcc_id();
        __builtin_amdgcn_s_waitcnt(0);
        unsigned nloc = st[0], nx = st[1];
        if (nloc == 0u) { xcd_barrier_complete(bar, x, G, nloc, nx); st[0] = nloc; st[1] = nx; }
        const unsigned old = xb_add(&bar[XB_XSUB(x)], 1u);
        const unsigned gen = old / nloc;
        if (old + 1u == (gen + 1u) * nloc) {
            __builtin_amdgcn_fence(__ATOMIC_RELEASE, "agent");
            asm volatile("s_waitcnt vmcnt(0)" ::: "memory");
            const unsigned og = xb_add(&bar[XB_TOP], 1u);
            const unsigned tg = og / nx;
            if (og + 1u == (tg + 1u) * nx) xb_add(&bar[XB_TOPGEN], 1u);
            else XB_SPIN(xb_ld(&bar[XB_TOPGEN]) == tg, bar);
            __builtin_amdgcn_fence(__ATOMIC_ACQUIRE, "agent");
            xb_add(&bar[XB_XGEN(x)], 1u);
            asm volatile("s_waitcnt vmcnt(0)" ::: "memory");
        } else {
            XB_SPIN(xb_ld(&bar[XB_XGEN(x)]) == gen, bar);
            __builtin_amdgcn_fence(__ATOMIC_ACQUIRE, "agent");
            asm volatile("s_waitcnt vmcnt(0)" ::: "memory");
        }
    }
    __syncthreads();
}

__device__ __forceinline__ bool unit_of(int M, int N, int G, int c, int i, int& pm, int& pn) {
    const int nM = M / 256, nN = N / 256, nwg = nM * nN; const long L = (long)i * G + c; if (L >= nwg) return false;
    int wgid = (int)L; { const int q = nwg / 8, r = nwg % 8, xcd = wgid % 8, off = wgid / 8; wgid = (xcd < r ? xcd * (q + 1) : r * (q + 1) + (xcd - r) * q) + off; }
    const int nig = pg8::WGM * nN, gid = wgid / nig, fm = gid * pg8::WGM, gsz = (nM - fm) < pg8::WGM ? (nM - fm) : pg8::WGM;
    pm = fm + ((wgid % nig) % gsz); pn = (wgid % nig) / gsz; return true;
}
__device__ __forceinline__ int lane_id_fresh() { int l; asm volatile("v_mbcnt_lo_u32_b32 %0, -1, 0\n\tv_mbcnt_hi_u32_b32 %0, -1, %0" : "=v"(l)); return l; }

constexpr int LDS_BYTES = 147456;
__global__ void __launch_bounds__(512, 2) fwd_mega(Args args) {
    extern __shared__ __attribute__((aligned(16))) unsigned char lds_raw[];
    LAS unsigned char* lds = (LAS unsigned char*)lds_raw;
    cg::grid_group grid = cg::this_grid();
    const int G = gridDim.x, bid = blockIdx.x;
    const int wave0 = __builtin_amdgcn_readfirstlane((int)threadIdx.x >> 6);
#define MKTID() (wave0 * 64 + lane_id_fresh())
    unsigned* BARW = (unsigned*)(args.ws + 6 * 65536);
    volatile LAS unsigned* BARST = (volatile LAS unsigned*)(lds + 139264);
    if (threadIdx.x == 0) { BARST[0] = 0u; BARST[1] = 0u; if (args.coop) (void)xb_add(&BARW[XB_XCNT(xb_xcc_id())], 1u); }
    __syncthreads();
#define GBAR() xcd_barrier(BARW, BARST, (unsigned)G, MKTID() == 0)
    const int NGW = G * 8, NGT = G * 512;
#define FRESH() int tid = MKTID(); asm volatile("" : "+v"(tid)); const int lane = tid & 63; const int wave = __builtin_amdgcn_readfirstlane(tid >> 6); \
    const int gw = bid * 8 + wave; const int gt = bid * 512 + tid; LAS float* scr = (LAS float*)(lds + wave * 16384); (void)lane; (void)gw; (void)gt; (void)scr
    unsigned char* ws = args.ws;
    const float* x = args.in[0]; const float* attn_norm_g = args.in[1]; const float* w_in = args.in[2]; const float* b_gate = args.in[3];
    const float* q_norm_g = args.in[4]; const float* w_uq = args.in[5]; const float* kv_norm_g = args.in[6]; const float* w_ukv = args.in[7];
    const float* w_o_mla = args.in[8]; const float* w_o_dil = args.in[9]; const float* w_out = args.in[10]; const float* ffn_norm_g = args.in[11];
    const float* w_up = args.in[12]; const float* conv_w = args.in[13]; const float* conv_b = args.in[14]; const float* w_down = args.in[15]; const float* final_norm_g = args.in[16];
    float* out = args.out;
    float* RSTD0 = (float*)(ws + WS_RSTD0); float* SSQQ = (float*)(ws + WS_SSQQ); float* SSQKV = (float*)(ws + WS_SSQKV); float* SSQ1 = (float*)(ws + WS_SSQ1); float* SSQ2 = (float*)(ws + WS_SSQ2);
    float* LSE = (float*)(ws + WS_LSE); f32x2v* ROPE = (f32x2v*)(ws + WS_ROPE);
    bf16* WUQ = (bf16*)(ws + WS_WUQ); bf16* WKV = (bf16*)(ws + WS_WKV); bf16* WOM = (bf16*)(ws + WS_WOM); bf16* WOD = (bf16*)(ws + WS_WOD); bf16* WOUT = (bf16*)(ws + WS_WOUT);
    bf16* WIN = (bf16*)(ws + WS_WIN); bf16* WDN = (bf16*)(ws + WS_WDN); bf16* WUP = (bf16*)args.out;
    bf16* XB = (bf16*)(ws + WS_A); bf16* OG = (bf16*)(ws + WS_A); bf16* X1B = (bf16*)(ws + WS_A);
    bf16* CQ = (bf16*)(ws + WS_CQ); bf16* CKV = (bf16*)(ws + WS_CKV); float* KPER = (float*)(ws + WS_KPER);
    bf16* DQ = (bf16*)(ws + WS_DQ); bf16* DK = (bf16*)(ws + WS_DK); bf16* DV = (bf16*)(ws + WS_DV);
    bf16* ATT = (bf16*)(ws + WS_ATT); bf16* DIL = (bf16*)(ws + WS_DIL);
    bf16* GA = (bf16*)(ws + WS_GA); bf16* GB = (bf16*)(ws + WS_GB);
    bf16* Q = (bf16*)(ws + WS_Q); bf16* KN = (bf16*)(ws + WS_KN); bf16* KPE = (bf16*)(ws + WS_KPE); bf16* V = (bf16*)(ws + WS_V); bf16* MERGEB = (bf16*)(ws + WS_MERGEB);
    bf16* U = (bf16*)(ws + WS_U); bf16* ACT = (bf16*)(ws + WS_ACT_REAL); float* HEADB = (float*)(ws + WS_U); float* TAILB = (float*)(ws + WS_U + 8 * MiB);
    float* MERGE = out;
    float* X1 = (float*)(ws + 164 * MiB);

    const int lo = args.ph_lo, hi = args.ph_hi;
#define IN(k) (lo <= (k) && (k) < hi)
#ifndef PROBE_DUP
#define PROBE_DUP 0
#endif
#define NREP(k) (((PROBE_DUP >> (k)) & 1) + 1)
#define REPSYNC() do { if (rep && args.coop) GBAR(); } while (0)
#define SEAM(k) do { if (IN(k) && IN((k) + 1)) { if (args.coop) { if ((k) == 0 && args.pad == 0x7fffffff) grid.sync();     \
        GBAR(); } } } while (0)
    float* DUMMY = (float*)(ws + 5 * 65536);

    if (IN(0)) for (int rep = 0; rep < NREP(0); ++rep) { REPSYNC(); FRESH(); int rot = 0;
        conv_matrix_wg(w_in, DM, 9536, WIN, DM, 0, attn_norm_g, 1, lds, bid, G, tid, rot);
        if (G != 256) {
        conv_matrix_wg(w_uq, 512, 1536, WUQ, 512, 0, q_norm_g, 0, lds, bid, G, tid, rot);
        conv_matrix_wg(w_ukv, 256, 2048, WKV, 256, 0, kv_norm_g, 2, lds, bid, G, tid, rot);
        conv_matrix_wg(w_o_mla, 1024, 2048, WOM, 1536, 0, nullptr, 0, lds, bid, G, tid, rot);
        conv_matrix_wg(w_o_dil, 512, 2048, WOM, 1536, 1024, nullptr, 0, lds, bid, G, tid, rot);
        conv_matrix_wg(w_out, 2048, 2048, WOUT, DM, 0, nullptr, 0, lds, bid, G, tid, rot);
        }
        for (int m = gw; m < T; m += NGW) row_to_bf16_rstd(x + (size_t)m * DM, XB + (size_t)m * DM, RSTD0 + m, lane);
        for (int i = gt; i < 4 * T; i += NGT) SSQQ[i] = 0.f;
        if (G != 256) for (int i = gt; i < SEQ * 32; i += NGT) { const int pos = i >> 5, f = i & 31; const float inv_freq = powf(10000.0f, -(float)(2 * f) / 64.0f); const float ang = (float)pos * inv_freq;
            float sn, cs; sincosf(ang, &sn, &cs); ROPE[i] = (f32x2v){cs, sn}; }
    }
    SEAM(0);
    if (IN(1)) for (int rep = 0; rep < NREP(1); ++rep) { REPSYNC();
        pg8::Gemm g{XB, WIN, T, N_IN_PAD, DM}; pg8::StaticOrder S; S.init(T, N_IN_PAD, G, bid);
        pg8::EpiProj E{CQ, CKV, DQ, DK, DV, GA, GB, KPER, RSTD0, rep ? nullptr : SSQQ, rep ? nullptr : SSQKV, b_gate};
        pg8::gemm_phase<pg8::EpiProj, pg8::StaticOrder, true, true>(lds, g, S, E, MKTID());
        if (G == 256 && bid >= 128 && rep == 0) {
            FRESH(); int rot = 0;
            conv_matrix_wg(w_uq, 512, 1536, WUQ, 512, 0, q_norm_g, 0, lds, bid - 128, 128, tid, rot);
            conv_matrix_wg(w_ukv, 256, 2048, WKV, 256, 0, kv_norm_g, 2, lds, bid - 128, 128, tid, rot);
            conv_matrix_wg(w_o_mla, 1024, 2048, WOM, 1536, 0, nullptr, 0, lds, bid - 128, 128, tid, rot);
            conv_matrix_wg(w_o_dil, 512, 2048, WOM, 1536, 1024, nullptr, 0, lds, bid - 128, 128, tid, rot);
            conv_matrix_wg(w_out, 2048, 2048, WOUT, DM, 0, nullptr, 0, lds, bid - 128, 128, tid, rot);
            conv_matrix_wg(w_up, DM, NUP, WUP, DM, 0, ffn_norm_g, 3, lds, bid - 128, 128, tid, rot);
            for (int i = (bid - 128) * 512 + tid; i < SEQ * 32; i += 128 * 512) { const int pos = i >> 5, f = i & 31; const float inv_freq = powf(10000.0f, -(float)(2 * f) / 64.0f); const float ang = (float)pos * inv_freq;
                float sn, cs; sincosf(ang, &sn, &cs); ROPE[i] = (f32x2v){cs, sn}; }
        }
    }
    SEAM(1);
    if (IN(2)) for (int rep = 0; rep < NREP(2); ++rep) { REPSYNC();
        { pg8::Gemm g{CQ, WUQ, T, 1536, 512}; pg8::StaticOrder S; S.init(T, 1536, G, bid);
          pg8::EpiRowScale E{Q, Q, 1000, 1536, SSQQ, 1.0f / 512.0f};
          pg8::gemm_phase<pg8::EpiRowScale, pg8::StaticOrder, true, true>(lds, g, S, E, MKTID()); }
        { pg8::Gemm g{CKV, WKV, T, 1024, 256}; pg8::StaticOrder S; S.init(T, 1024, G, (bid + 128) % G);
          pg8::EpiRowScale E{KN, KN, 1000, 1024, SSQKV, 1.0f / 256.0f};
          pg8::gemm_phase<pg8::EpiRowScale, pg8::StaticOrder, true, true>(lds, g, S, E, MKTID()); }
        { pg8::Gemm g{WKV + 1024 * 256, CKV, 1024, T, 256}; pg8::StaticOrder S; S.init(1024, T, G, bid);
          pg8::EpiColScale E{V, T, SSQKV, 1.0f / 256.0f};
          pg8::gemm_phase<pg8::EpiColScale, pg8::StaticOrder, true, true>(lds, g, S, E, MKTID()); }
        FRESH();
        for (int i = gt; i < T * 32; i += NGT) { const int t = i >> 5, f = i & 31; const float x1 = KPER[(size_t)t * 64 + f], x2 = KPER[(size_t)t * 64 + 32 + f]; const f32x2v cs = ROPE[(t & (SEQ - 1)) * 32 + f];
            KPE[(size_t)t * 64 + f] = (bf16)(cvt_pk_bf16(x1 * cs.x - x2 * cs.y, 0.f) & 0xffffu); KPE[(size_t)t * 64 + 32 + f] = (bf16)(cvt_pk_bf16(x2 * cs.x + x1 * cs.y, 0.f) & 0xffffu); }
        for (int uid = bid; uid < 768; uid += G) {
            const int g = uid >> 8, rem = uid & 255, b = rem >> 6, hs = (rem >> 4) & 3, sub = rem & 15;
            const int dil = g == 0 ? 1 : (g == 1 ? 4 : 16), nblk = 16 / dil, r = sub / nblk, ublk = sub % nblk;
            const float slope = exp2f(-8.0f * (float)(g * 4 + hs + 1) / 12.0f);
            const size_t rowb = (size_t)b * SEQ + r; const int colb = g * 512 + hs * 128;
#ifndef SKIP_DIL
            attn_unit<128, false, false>(lds, DQ + rowb * 1536 + colb, (long)dil * 1536, DK + rowb * 1536 + colb, (long)dil * 1536, nullptr, 0, DV + rowb * 1536 + colb, (long)dil * 1536,
                OG + (size_t)g * T * 512 + rowb * 512 + hs * 128, (long)dil * 512, LSE + ((size_t)g * T + rowb) * 4 + hs, (long)dil * 4, ublk * 256, 128,
                0.08838834764831845f * 1.4426950408889634f, slope * (float)dil * 1.4426950408889634f, nullptr, MKTID());
#endif
        }
    }
    SEAM(2);
    if (IN(3)) for (int rep = 0; rep < NREP(3); ++rep) { REPSYNC();
        for (int it = bid; it < 256; it += G) {
            const int bh = it >> 3, s = it & 7, b = bh >> 3, h = bh & 7;
            const size_t rowb = (size_t)b * SEQ;
#pragma unroll 1
            for (int k = 0; k < 2; ++k) { const int qb = k == 0 ? 15 - s : s;
#ifndef SKIP_MLA
                attn_unit<192, true, true>(lds, Q + rowb * 1536 + h * 192, 1536, KN + rowb * 1024 + h * 128, 1024, KPE + rowb * 64, 64, V + (size_t)(h * 128) * T + rowb, T,
                    ATT + rowb * 1536 + h * 128, 1536, nullptr, 0, qb * 256, 1 << 24, 0.07216878364870322f * 1.4426950408889634f, 0.f, ROPE, MKTID());
#endif
            }
        }
        FRESH();
        for (int i = gt; i < T * 64; i += NGT) {
            const int t = i >> 6, hs = (i >> 4) & 3, c = i & 15;
            const float l0 = LSE[(size_t)t * 4 + hs], l1 = LSE[((size_t)T + t) * 4 + hs], l2 = LSE[((size_t)2 * T + t) * 4 + hs];
            const float mx = fmaxf(l0, fmaxf(l1, l2)); float e0 = __expf(l0 - mx), e1 = __expf(l1 - mx), e2 = __expf(l2 - mx); const float inv = 1.0f / (e0 + e1 + e2); e0 *= inv; e1 *= inv; e2 *= inv;
            const size_t off = (size_t)t * 512 + hs * 128 + c * 8;
            const v4u a = *(const v4u*)(OG + off), b2 = *(const v4u*)(OG + (size_t)T * 512 + off), c2 = *(const v4u*)(OG + (size_t)2 * T * 512 + off); v4u o;
#pragma unroll
            for (int j = 0; j < 4; ++j) o[j] = cvt_pk_bf16(e0 * bflo(a[j]) + e1 * bflo(b2[j]) + e2 * bflo(c2[j]), e0 * bfhi(a[j]) + e1 * bfhi(b2[j]) + e2 * bfhi(c2[j]));
            *(v4u*)(ATT + (size_t)t * 1536 + 1024 + hs * 128 + c * 8) = o;
        }
    }
    SEAM(3);
    if (IN(4)) for (int rep = 0; rep < NREP(4); ++rep) { REPSYNC();
#ifndef PROBE_CONV
#define PROBE_CONV 1
#endif
        for (int r2 = 0; r2 < PROBE_CONV; ++r2) { FRESH(); int rot = 0;
        if (G != 256) conv_matrix_wg(w_up, DM, NUP, WUP, DM, 0, ffn_norm_g, 3, lds, bid, G, tid, rot);
        if (G != 256) conv_matrix_wg(w_down, DFF, DM, WDN, DFF, 0, nullptr, 0, lds, bid, G, tid, rot); }
        __syncthreads();
        { pg8::Gemm g{ATT, WOM, T, DM, 1536}; pg8::StaticOrder S; S.init(T, DM, G, bid);
          pg8::EpiMerge E{GA, GB, MERGEB, 16};
          pg8::gemm_phase<pg8::EpiMerge, pg8::StaticOrder, true, true>(lds, g, S, E, MKTID()); }
    }
    SEAM(4);
    if (IN(5)) for (int rep = 0; rep < NREP(5); ++rep) { REPSYNC();
        pg8::Gemm g{MERGEB, WOUT, T, DM, DM}; pg8::StaticOrder S; S.init(T, DM, G, bid);
        pg8::EpiResid E{x, X1, X1B, rep ? DUMMY : SSQ1};
        pg8::gemm_phase<pg8::EpiResid, pg8::StaticOrder, true, true>(lds, g, S, E, MKTID());
    }
    SEAM(5);
    if (IN(6)) for (int rep = 0; rep < NREP(6); ++rep) { REPSYNC();
        pg8::Gemm g{X1B, WUP, T, NUP, DM}; pg8::StaticOrder S; S.init(T, NUP, G, bid);
        pg8::EpiConvAct E{ACT, SSQ1, conv_w, conv_b, HEADB, TAILB, lds + 131072};
        pg8::gemm_phase<pg8::EpiConvAct, pg8::StaticOrder, true, true>(lds, g, S, E, MKTID());
        if (G == 256 && bid >= 192 && rep == 0) {
            FRESH(); int rot = 0;
            conv_matrix_wg(w_down, DFF, DM, WDN, DFF, 0, nullptr, 0, lds, bid - 192, 64, tid, rot);
        }
    }
    SEAM(6);
    if (IN(10)) for (int rep = 0; rep < NREP(10); ++rep) { REPSYNC();
        pg8::Gemm g{ACT, WDN, T, DM, DFF}; pg8::StaticOrder S; S.init(T, DM, G, bid);
        { FRESH();
#pragma unroll 1
          for (int i = 0; i < 64; ++i) { int pm, pn_; if (!unit_of(T, DM, G, bid, i, pm, pn_)) break; if ((pm & 15) == 0) continue;
            const float* tl = TAILB + (size_t)(pm - 1) * 2 * NUP; const float* hd = HEADB + (size_t)pm * 2 * NUP;
            for (int c = tid; c < DFF; c += 512) {
                const int colu = (c >> 7) * 256 + (c & 127), colg = colu + 128;
                const float um2 = tl[colu], um1 = tl[NUP + colu], u0 = hd[colu], u1 = hd[NUP + colu];
                const float gm2 = tl[colg], gm1 = tl[NUP + colg], g0 = hd[colg], g1 = hd[NUP + colg];
                const float wu0 = conv_w[c], wu1 = conv_w[NUP + c], wu2 = conv_w[2 * NUP + c], bu = conv_b[c];
                const float wg0 = conv_w[DFF + c], wg1 = conv_w[NUP + DFF + c], wg2 = conv_w[2 * NUP + DFF + c], bg = conv_b[DFF + c];
                const float cu0 = bu + wu0 * um2 + wu1 * um1 + wu2 * u0, cu1 = bu + wu0 * um1 + wu1 * u0 + wu2 * u1;
                const float cg0 = bg + wg0 * gm2 + wg1 * gm1 + wg2 * g0, cg1 = bg + wg0 * gm1 + wg1 * g0 + wg2 * g1;
                ACT[(size_t)(pm * 256) * DFF + c] = (bf16)(cvt_pk_bf16(cu0 * cg0 * __builtin_amdgcn_rcpf(1.0f + __expf(-cg0)), 0.f) & 0xffffu);
                ACT[(size_t)(pm * 256 + 1) * DFF + c] = (bf16)(cvt_pk_bf16(cu1 * cg1 * __builtin_amdgcn_rcpf(1.0f + __expf(-cg1)), 0.f) & 0xffffu);
            } }
          asm volatile("s_waitcnt vmcnt(0)" ::: "memory"); __syncthreads(); }
        pg8::EpiResid E{X1, out, nullptr, rep ? DUMMY : SSQ2};
        pg8::gemm_phase<pg8::EpiResid, pg8::StaticOrder, true, true>(lds, g, S, E, MKTID());
    }
    SEAM(10);
    if (IN(11)) { FRESH();
        for (int m = gw; m < T; m += NGW) {
            const float rs = rsqrtf(SSQ2[m] * (1.0f / DM) + 1e-6f);
            f32x4* xr = (f32x4*)(out + (size_t)m * DM) + lane; const f32x4* gr = (const f32x4*)final_norm_g + lane;
#pragma unroll
            for (int j = 0; j < 8; ++j) { const f32x4 v = xr[64 * j]; const f32x4 gg = gr[64 * j]; xr[64 * j] = v * rs * gg; }
        }
    }
#undef IN
#undef SEAM
}

#ifndef MK_N_LAUNCHES
#define MK_N_LAUNCHES 1
#endif
extern "C" void kernel_launch(void* const* d_in, const int* in_sizes, int n_in, void* d_out, int out_size, void* d_ws, size_t ws_size, hipStream_t stream) {
    static int grid = 0;
    if (grid == 0) {
        int dev = 0, cus = 0, per_cu = 0;
        if (n_in != 17 || out_size != T * DM || ws_size < WS_END) { fprintf(stderr, "kernel_launch: unexpected shapes / workspace (%d inputs, out %d, ws %zu)\n", n_in, out_size, ws_size); grid = -1; return; }
        (void)hipGetDevice(&dev);
        (void)hipDeviceGetAttribute(&cus, hipDeviceAttributeMultiprocessorCount, dev);
        (void)hipFuncSetAttribute((const void*)fwd_mega, hipFuncAttributeMaxDynamicSharedMemorySize, LDS_BYTES);
        (void)hipOccupancyMaxActiveBlocksPerMultiprocessor(&per_cu, (const void*)fwd_mega, 512, LDS_BYTES);
        if (per_cu < 1) per_cu = 1;
        grid = cus * per_cu;
        if (grid % 8 != 0 || grid < 8) grid = -1;
    }
    if (grid < 0) return;
    Args a{};
    for (int i = 0; i < 17; ++i) a.in[i] = (const float*)d_in[i];
    a.out = (float*)d_out; a.ws = (unsigned char*)d_ws;
#if MK_N_LAUNCHES == 1
    a.ph_lo = 0; a.ph_hi = 12; a.coop = 1;
    (void)hipMemsetAsync((unsigned char*)d_ws + 6 * 65536, 0, XCD_BAR_WORDS * 4, stream);
    void* kargs[] = {&a};
    hipError_t e = hipLaunchCooperativeKernel((const void*)fwd_mega, dim3(grid), dim3(512), kargs, LDS_BYTES, stream);
    if (e != hipSuccess) fprintf(stderr, "cooperative launch failed: %s (grid %d)\n", hipGetErrorString(e), grid);
#else
    for (int p = 0; p < 12; ++p) { a.ph_lo = p; a.ph_hi = p + 1; a.coop = 0; hipLaunchKernelGGL(fwd_mega, dim3(grid), dim3(512), LDS_BYTES, stream, a); }
#endif
}
```

```cpp
#include <hip/hip_runtime.h>
#include <hip/hip_cooperative_groups.h>
#include <cstdio>
#include <cstdint>
namespace cg = cooperative_groups;
namespace pg8 {
#define PG8_LAS __attribute__((address_space(3)))
typedef unsigned short bf16_t;
typedef short bf16x8 __attribute__((ext_vector_type(8)));
typedef float f32x4 __attribute__((ext_vector_type(4)));
typedef unsigned u32x4 __attribute__((ext_vector_type(4)));
constexpr int BM = 256, BK = 64, HALF = 128, HTB = HALF * BK * 2  , STAGE_BYTES = 8 * HTB, NXCD = 8, WGM = 2;

__host__ __device__ __forceinline__ int lds_byte(int r, int c) { const int st = (r >> 4) * 2 + (c >> 5), rr = r & 15, cc = c & 31, ob = rr * 64 + cc * 2; return st * 1024 + (ob ^ (((ob >> 9) & 1) << 5)); }
__host__ __device__ __forceinline__ void stage_rc(int b, int& R, int& C) { const int st = b / 1024, sb = b % 1024, swz = sb ^ (((sb >> 9) & 1) << 5); R = (st >> 1) * 16 + swz / 64; C = (st & 1) * 32 + (swz % 64) / 2; }
__host__ __device__ __forceinline__ int perm32(int rho) { const int n = rho >> 4, i = rho & 15; return 8 * (i >> 2) + 4 * n + (i & 3); }

struct Unit { int pm, pn; };
struct Gemm { const bf16_t* A; const bf16_t* Bt; int M, N, K; };

struct StaticOrder {
    int nM, nN, nwg, G, c;
    __host__ __device__ void init(int M, int N, int G_, int c_) { nM = M / BM; nN = N / BM; nwg = nM * nN; G = G_; c = c_; }
    __host__ __device__ bool next(int i, Unit& u) const {
        const long L = (long)i * G + c; if (L >= nwg) return false;
        int wgid = (int)L; { const int q = nwg / NXCD, r = nwg % NXCD, xcd = wgid % NXCD, off = wgid / NXCD; wgid = (xcd < r ? xcd * (q + 1) : r * (q + 1) + (xcd - r) * q) + off; }
        const int nig = WGM * nN, gid = wgid / nig, fm = gid * WGM, gsz = (nM - fm) < WGM ? (nM - fm) : WGM;
        u.pm = fm + ((wgid % nig) % gsz); u.pn = (wgid % nig) / gsz; return true;
    }
    __device__ __forceinline__ void a_ready(const Unit&) const {}
    __device__ __forceinline__ void done(const Unit&) const {}
};

__device__ __forceinline__ unsigned cvt_pk_bf16(float lo, float hi) { unsigned r; asm volatile("v_cvt_pk_bf16_f32 %0, %1, %2" : "=v"(r) : "v"(lo), "v"(hi)); return r; }
typedef float f32x2 __attribute__((ext_vector_type(2)));
typedef unsigned u32x2 __attribute__((ext_vector_type(2)));
constexpr float NORM_EPS_F = 1e-6f;
__device__ __forceinline__ float bf_lo(unsigned w) { return __uint_as_float(w << 16); }
__device__ __forceinline__ float bf_hi(unsigned w) { return __uint_as_float(w & 0xffff0000u); }
__device__ __forceinline__ u32x4 pack8(const f32x4 a, const f32x4 b) { u32x4 w; w.x = cvt_pk_bf16(a[0], a[1]); w.y = cvt_pk_bf16(a[2], a[3]); w.z = cvt_pk_bf16(b[0], b[1]); w.w = cvt_pk_bf16(b[2], b[3]); return w; }
__device__ __forceinline__ float sq8(const f32x4 a, const f32x4 b) { return (a[0] * a[0] + a[1] * a[1]) + (a[2] * a[2] + a[3] * a[3]) + (b[0] * b[0] + b[1] * b[1]) + (b[2] * b[2] + b[3] * b[3]); }
__device__ __forceinline__ float sigm(float v) { return __builtin_amdgcn_rcpf(1.0f + __expf(-v)); }

struct EpiProj {
    static constexpr bool PERM = true, AFTER_DRAIN = false, HAS_MIDK = false;
    bf16_t *CQ, *CKV, *DQ, *DK, *DV, *GA, *GB; float* KPER; const float* rstd0; float *ssq_q, *ssq_kv; const float* b_gate;
    __device__ __forceinline__ void operator()(const f32x4 (&acc)[2][2][4][2], const Unit& u, int wr, int wc, int fr, int fq) const {
        const int pn = u.pn; const int row0 = u.pm * BM + wr * 64 + fr; const int cw = wc * 32 + 8 * fq;
        bf16_t* base = CQ; int ldc = 512, c0 = 0; const float* bias = nullptr; float* ssq = nullptr;
        if (pn < 2) { base = CQ; ldc = 512; c0 = pn * 256; ssq = ssq_q; }
        else if (pn == 2) { base = CKV; ldc = 256; c0 = 0; ssq = ssq_kv; }
        else if (pn == 3) { base = nullptr; }
        else if (pn < 10) { base = DQ; ldc = 1536; c0 = (pn - 4) * 256; }
        else if (pn < 16) { base = DK; ldc = 1536; c0 = (pn - 10) * 256; }
        else if (pn < 22) { base = DV; ldc = 1536; c0 = (pn - 16) * 256; }
        else if (pn < 30) { base = GA; ldc = 2048; c0 = (pn - 22) * 256; bias = b_gate + c0; }
        else { base = GB; ldc = 2048; c0 = (pn - 30) * 256; bias = b_gate + 2048 + c0; }
        if (base == nullptr) {
            if (wc < 2) {
#pragma unroll
                for (int ai = 0; ai < 2; ++ai)
#pragma unroll
                    for (int m = 0; m < 4; ++m) { const int row = row0 + ai * HALF + m * 16; const float rs = rstd0[row];
                        float* p = KPER + (size_t)row * 64 + cw; *(f32x4*)p = acc[ai][0][m][0] * rs; *(f32x4*)(p + 4) = acc[ai][0][m][1] * rs; }
            }
            return;
        }
        f32x4 bv[2][2];
#pragma unroll
        for (int bj = 0; bj < 2; ++bj)
#pragma unroll
            for (int n = 0; n < 2; ++n) bv[bj][n] = bias ? *(const f32x4*)(bias + bj * HALF + cw + 4 * n) : (f32x4){0.f, 0.f, 0.f, 0.f};
#pragma unroll
        for (int ai = 0; ai < 2; ++ai)
#pragma unroll
            for (int m = 0; m < 4; ++m) { const int row = row0 + ai * HALF + m * 16; const float rs = rstd0[row]; bf16_t* rowp = base + (size_t)row * ldc + c0 + cw; float s = 0.f;
#pragma unroll
                for (int bj = 0; bj < 2; ++bj) { f32x4 v0 = acc[ai][bj][m][0] * rs, v1 = acc[ai][bj][m][1] * rs;
                    if (bias) { v0 = v0 + bv[bj][0]; v1 = v1 + bv[bj][1];
#pragma unroll
                        for (int e = 0; e < 4; ++e) { v0[e] = sigm(v0[e]); v1[e] = sigm(v1[e]); } }
                    s += sq8(v0, v1);
                    *(u32x4*)(rowp + bj * HALF) = pack8(v0, v1); }
                if (ssq) { s += __shfl_xor(s, 16); s += __shfl_xor(s, 32); if (fq == 0) atomicAdd(ssq + row, s); } }
    }
};

struct EpiRowScale {
    static constexpr bool PERM = true, AFTER_DRAIN = false, HAS_MIDK = false;
    bf16_t *O0, *O1; int split, ldc; const float* ssq; float inv_dim;
    __device__ __forceinline__ void operator()(const f32x4 (&acc)[2][2][4][2], const Unit& u, int wr, int wc, int fr, int fq) const {
        const int pn = u.pn; const int row0 = u.pm * BM + wr * 64 + fr; const int cw = wc * 32 + 8 * fq;
        bf16_t* base = pn < split ? O0 : O1; const int c0 = (pn < split ? pn : pn - split) * 256;
#pragma unroll
        for (int ai = 0; ai < 2; ++ai)
#pragma unroll
            for (int m = 0; m < 4; ++m) { const int row = row0 + ai * HALF + m * 16; const float rs = rsqrtf(ssq[row] * inv_dim + NORM_EPS_F); bf16_t* rowp = base + (size_t)row * ldc + c0 + cw;
#pragma unroll
                for (int bj = 0; bj < 2; ++bj) *(u32x4*)(rowp + bj * HALF) = pack8(acc[ai][bj][m][0] * rs, acc[ai][bj][m][1] * rs); }
    }
};

struct EpiGate {
    static constexpr bool PERM = true, AFTER_DRAIN = false, HAS_MIDK = false;
    const bf16_t* G; const float* addin; float* outf; bf16_t* outb;
    __device__ __forceinline__ void operator()(const f32x4 (&acc)[2][2][4][2], const Unit& u, int wr, int wc, int fr, int fq) const {
        const int row0 = u.pm * BM + wr * 64 + fr; const int col0 = u.pn * BM + wc * 32 + 8 * fq;
#pragma unroll
        for (int ai = 0; ai < 2; ++ai)
#pragma unroll
            for (int m = 0; m < 4; ++m) { const size_t off = (size_t)(row0 + ai * HALF + m * 16) * 2048 + col0;
#pragma unroll
                for (int bj = 0; bj < 2; ++bj) { const u32x4 g = *(const u32x4*)(G + off + bj * HALF);
                    f32x4 v0 = acc[ai][bj][m][0] * (f32x4){bf_lo(g.x), bf_hi(g.x), bf_lo(g.y), bf_hi(g.y)};
                    f32x4 v1 = acc[ai][bj][m][1] * (f32x4){bf_lo(g.z), bf_hi(g.z), bf_lo(g.w), bf_hi(g.w)};
                    if (addin) { v0 = v0 + *(const f32x4*)(addin + off + bj * HALF); v1 = v1 + *(const f32x4*)(addin + off + bj * HALF + 4); }
                    if (outf) { *(f32x4*)(outf + off + bj * HALF) = v0; *(f32x4*)(outf + off + bj * HALF + 4) = v1; }
                    if (outb) *(u32x4*)(outb + off + bj * HALF) = pack8(v0, v1); } }
    }
};

struct EpiResid {
    static constexpr bool PERM = true, AFTER_DRAIN = false, HAS_MIDK = false;
    const float* resid; float* outf; bf16_t* outb; float* ssq;
    __device__ __forceinline__ void operator()(const f32x4 (&acc)[2][2][4][2], const Unit& u, int wr, int wc, int fr, int fq) const {
        const int row0 = u.pm * BM + wr * 64 + fr; const int col0 = u.pn * BM + wc * 32 + 8 * fq;
#ifndef EPI_REP
#define EPI_REP 1
#endif
#pragma unroll 1
        for (int rp = 0; rp < 1; ++rp)
#pragma unroll
        for (int ai = 0; ai < 2; ++ai)
#pragma unroll
            for (int m = 0; m < 4; ++m) { const int row = row0 + ai * HALF + m * 16; const size_t off = (size_t)row * 2048 + col0; float s = 0.f;
#pragma unroll
                for (int bj = 0; bj < 2; ++bj) { const f32x4 v0 = acc[ai][bj][m][0] + *(const f32x4*)(resid + off + bj * HALF), v1 = acc[ai][bj][m][1] + *(const f32x4*)(resid + off + bj * HALF + 4);
                    s += sq8(v0, v1);
                    *(f32x4*)(outf + off + bj * HALF) = v0; *(f32x4*)(outf + off + bj * HALF + 4) = v1;
                    if (outb) *(u32x4*)(outb + off + bj * HALF) = pack8(v0, v1); }
                s += __shfl_xor(s, 16); s += __shfl_xor(s, 32); if (fq == 0 && rp == 0) atomicAdd(ssq + row, s); asm volatile("" ::: "memory"); }
    }
};


#define PG8_DPPV(NAME, CTRLSTR) __device__ __forceinline__ f32x4 NAME(f32x4 oldv, const f32x4 v) { \
    _Pragma("unroll") for (int e = 0; e < 4; ++e) { float o = oldv[e]; const float s_ = v[e]; \
        asm volatile("s_nop 1\n\tv_mov_b32_dpp %0, %1 " CTRLSTR " row_mask:0xf bank_mask:0xf" : "+v"(o) : "v"(s_)); oldv[e] = o; } \
    return oldv; }
PG8_DPPV(dpp_shr1, "row_shr:1")
PG8_DPPV(dpp_shr2, "row_shr:2")
PG8_DPPV(dpp_shl15, "row_shl:15")
PG8_DPPV(dpp_shl14, "row_shl:14")
__device__ __forceinline__ f32x4 prev1(const f32x4 xp, const f32x4 x) { const f32x4 z = (f32x4){0.f, 0.f, 0.f, 0.f}; return dpp_shr1(dpp_shl15(z, xp), x); }
__device__ __forceinline__ f32x4 prev2(const f32x4 xp, const f32x4 x) { const f32x4 z = (f32x4){0.f, 0.f, 0.f, 0.f}; return dpp_shr2(dpp_shl14(z, xp), x); }
struct EpiConvAct {
    static constexpr bool PERM = true, AFTER_DRAIN = false, HAS_MIDK = false;
    bf16_t* ACT; const float* ssq; const float* conv_w; const float* conv_b; float* HEAD; float* TAIL; PG8_LAS unsigned char* xch;
    static __device__ __forceinline__ int slot(int ai, int wr, int wc, int rr, int fq) { return ((((ai * 2 + wr) * 4 + wc) * 2 + rr) * 4 + fq) * 4; }
    __device__ __forceinline__ void operator()(const f32x4 (&acc)[2][2][4][2], const Unit& u, int wr, int wc, int fr, int fq) const {
        PG8_LAS f32x4* X = (PG8_LAS f32x4*)xch;
        const int row0 = u.pm * BM + wr * 64 + fr; const int cw = wc * 32 + 8 * fq; const int colt = u.pn * 256;
        float rs[2][4];
#pragma unroll
        for (int ai = 0; ai < 2; ++ai)
#pragma unroll
            for (int m = 0; m < 4; ++m) rs[ai][m] = rsqrtf(ssq[row0 + ai * HALF + m * 16] * (1.0f / 2048.0f) + NORM_EPS_F);
        if (fr >= 14) {
#pragma unroll
            for (int ai = 0; ai < 2; ++ai) { const int b = slot(ai, wr, wc, fr - 14, fq);
#pragma unroll
                for (int bj = 0; bj < 2; ++bj)
#pragma unroll
                    for (int n = 0; n < 2; ++n) { const f32x4 v = acc[ai][bj][3][n] * rs[ai][3]; X[b + bj * 2 + n] = v;
                        if (ai == 1 && wr == 1) *(f32x4*)(TAIL + (size_t)(u.pm * 2 + (fr - 14)) * 11008 + colt + bj * HALF + cw + 4 * n) = v; } }
        }
        if (fr < 2 && wr == 0) {
#pragma unroll
            for (int bj = 0; bj < 2; ++bj)
#pragma unroll
                for (int n = 0; n < 2; ++n) *(f32x4*)(HEAD + (size_t)(u.pm * 2 + fr) * 11008 + colt + bj * HALF + cw + 4 * n) = acc[0][bj][0][n] * rs[0][0];
        }
        asm volatile("s_waitcnt lgkmcnt(0)" ::: "memory"); __builtin_amdgcn_s_barrier(); asm volatile("" ::: "memory");
#pragma unroll
        for (int n = 0; n < 2; ++n) {
            const int c = u.pn * 128 + cw + 4 * n;
            f32x4 wu[3], wg[3];
#pragma unroll
            for (int k = 0; k < 3; ++k) { wu[k] = *(const f32x4*)(conv_w + (size_t)k * 11008 + c); wg[k] = *(const f32x4*)(conv_w + (size_t)k * 11008 + 5504 + c); }
            const f32x4 bu = *(const f32x4*)(conv_b + c), bg = *(const f32x4*)(conv_b + 5504 + c);
#pragma unroll
            for (int ai = 0; ai < 2; ++ai) {
                f32x4 pu = (f32x4){0.f, 0.f, 0.f, 0.f}, pg = pu;
                if (!(ai == 0 && wr == 0)) { const int b = slot(wr == 1 ? ai : ai - 1, wr ^ 1, wc, fr & 1, fq); pu = X[b + n]; pg = X[b + 2 + n]; }
#pragma unroll
                for (int m = 0; m < 4; ++m) {
                    const f32x4 xu = acc[ai][0][m][n] * rs[ai][m], xg = acc[ai][1][m][n] * rs[ai][m];
                    const f32x4 p1u = prev1(pu, xu), p2u = prev2(pu, xu), p1g = prev1(pg, xg), p2g = prev2(pg, xg);
                    const f32x4 cu = bu + wu[0] * p2u + wu[1] * p1u + wu[2] * xu, cgt = bg + wg[0] * p2g + wg[1] * p1g + wg[2] * xg;
                    float a[4];
#pragma unroll
                    for (int e = 0; e < 4; ++e) a[e] = cu[e] * cgt[e] * __builtin_amdgcn_rcpf(1.0f + __expf(-cgt[e]));
                    u32x2 w; w.x = cvt_pk_bf16(a[0], a[1]); w.y = cvt_pk_bf16(a[2], a[3]);
                    *(u32x2*)(ACT + (size_t)(row0 + ai * HALF + m * 16) * 5504 + c) = w;
                    pu = xu; pg = xg;
                }
            }
        }
    }
};

struct EpiMerge {
    static constexpr bool PERM = true, AFTER_DRAIN = false, HAS_MIDK = true;
    const bf16_t* GA; const bf16_t* GB; bf16_t* outb; int midk_t;
    __device__ __forceinline__ void midk(f32x4 (&acc)[2][2][4][2], const Unit& u, int wr, int wc, int fr, int fq) const {
        int row0 = u.pm * BM + wr * 64 + fr; const int col0 = u.pn * BM + wc * 32 + 8 * fq;
        asm volatile("" : "+v"(row0));
#pragma unroll
        for (int ai = 0; ai < 2; ++ai)
#pragma unroll
            for (int m = 0; m < 4; ++m) { const unsigned off = (unsigned)((row0 + ai * HALF + m * 16) * 2048 + col0);
#pragma unroll
                for (int bj = 0; bj < 2; ++bj) { const u32x4 a = *(const u32x4*)(GA + off + bj * HALF), b = *(const u32x4*)(GB + off + bj * HALF);
                    f32x4 r0, r1;
                    r0[0] = bf_lo(a.x) * __builtin_amdgcn_rcpf(fmaxf(bf_lo(b.x), 1e-20f)); r0[1] = bf_hi(a.x) * __builtin_amdgcn_rcpf(fmaxf(bf_hi(b.x), 1e-20f)); r0[2] = bf_lo(a.y) * __builtin_amdgcn_rcpf(fmaxf(bf_lo(b.y), 1e-20f)); r0[3] = bf_hi(a.y) * __builtin_amdgcn_rcpf(fmaxf(bf_hi(b.y), 1e-20f));
                    r1[0] = bf_lo(a.z) * __builtin_amdgcn_rcpf(fmaxf(bf_lo(b.z), 1e-20f)); r1[1] = bf_hi(a.z) * __builtin_amdgcn_rcpf(fmaxf(bf_hi(b.z), 1e-20f)); r1[2] = bf_lo(a.w) * __builtin_amdgcn_rcpf(fmaxf(bf_lo(b.w), 1e-20f)); r1[3] = bf_hi(a.w) * __builtin_amdgcn_rcpf(fmaxf(bf_hi(b.w), 1e-20f));
                    acc[ai][bj][m][0] = acc[ai][bj][m][0] * r0; acc[ai][bj][m][1] = acc[ai][bj][m][1] * r1; } }
    }
    __device__ __forceinline__ void operator()(const f32x4 (&acc)[2][2][4][2], const Unit& u, int wr, int wc, int fr, int fq) const {
        const int row0 = u.pm * BM + wr * 64 + fr; const int col0 = u.pn * BM + wc * 32 + 8 * fq;
#pragma unroll
        for (int ai = 0; ai < 2; ++ai)
#pragma unroll
            for (int m = 0; m < 4; ++m) { const size_t off = (size_t)(row0 + ai * HALF + m * 16) * 2048 + col0;
#pragma unroll
                for (int bj = 0; bj < 2; ++bj) { const u32x4 b = *(const u32x4*)(GB + off + bj * HALF);
                    const f32x4 g0 = (f32x4){fmaxf(bf_lo(b.x), 1e-20f), fmaxf(bf_hi(b.x), 1e-20f), fmaxf(bf_lo(b.y), 1e-20f), fmaxf(bf_hi(b.y), 1e-20f)};
                    const f32x4 g1 = (f32x4){fmaxf(bf_lo(b.z), 1e-20f), fmaxf(bf_hi(b.z), 1e-20f), fmaxf(bf_lo(b.w), 1e-20f), fmaxf(bf_hi(b.w), 1e-20f)};
                    *(u32x4*)(outb + off + bj * HALF) = pack8(acc[ai][bj][m][0] * g0, acc[ai][bj][m][1] * g1); } }
    }
};

struct EpiColScale {
    static constexpr bool PERM = true, AFTER_DRAIN = false, HAS_MIDK = false;
    bf16_t* O; int ldc; const float* ssq; float inv_dim;
    __device__ __forceinline__ void operator()(const f32x4 (&acc)[2][2][4][2], const Unit& u, int wr, int wc, int fr, int fq) const {
        int row0 = u.pm * BM + wr * 64 + fr; const int col0 = u.pn * BM + wc * 32 + 8 * fq;
        asm volatile("" : "+v"(row0));
#pragma unroll
        for (int bj = 0; bj < 2; ++bj)
#pragma unroll
            for (int n = 0; n < 2; ++n) {
                f32x4 c = *(const f32x4*)(ssq + col0 + bj * HALF + 4 * n);
#pragma unroll
                for (int e = 0; e < 4; ++e) c[e] = rsqrtf(c[e] * inv_dim + NORM_EPS_F);
#pragma unroll
                for (int ai = 0; ai < 2; ++ai)
#pragma unroll
                    for (int m = 0; m < 4; ++m) { const f32x4 v = acc[ai][bj][m][n] * c; u32x2 w; w.x = cvt_pk_bf16(v[0], v[1]); w.y = cvt_pk_bf16(v[2], v[3]);
                        *(u32x2*)(O + (size_t)(row0 + ai * HALF + m * 16) * ldc + col0 + bj * HALF + 4 * n) = w; }
            }
    }
};

struct RangeOrder {
    StaticOrder S; int i0, n;
    __host__ __device__ bool next(int i, Unit& u) const { return i < n && S.next(i0 + i, u); }
    __device__ __forceinline__ void a_ready(const Unit&) const {}
    __device__ __forceinline__ void done(const Unit&) const {}
};
template <class Epi, class Sched, bool ALIGN_EPI = false, bool SP2 = false>
__device__ __forceinline__ void gemm_phase(PG8_LAS unsigned char* lds, const Gemm g, const Sched& S, const Epi& E, const int tid_in) {
    int tid_ = tid_in; asm volatile("" : "+v"(tid_));
    const int tid = tid_, wid = __builtin_amdgcn_readfirstlane(tid >> 6), lane = tid & 63, wr = wid >> 2, wc = wid & 3, fr = lane & 15, fq = lane >> 4;
    const int K = g.K, nt = K / BK;
    unsigned voffA[2], voffB[2];
#pragma unroll
    for (int i = 0; i < 2; ++i) { int R, C; stage_rc(tid * 16 + i * 8192, R, C); const int Rb = Epi::PERM ? ((R & ~31) + perm32(R & 31)) : R;
        voffA[i] = (unsigned)(R * K + C) * 2u; voffB[i] = (unsigned)(Rb * K + C) * 2u; }
    const size_t kstep = (size_t)(BK * 2);
    const size_t hstep = (size_t)HALF * K * 2;
    const size_t tstep = 2 * hstep;
    const unsigned ldsw = (unsigned)wid * 1024u;
    const int aoff = lds_byte(wr * 64 + fr, fq * 8), boff = lds_byte(wc * 32 + fr, fq * 8);
#define PG8_SA(b, h) (((b) * 2 + (h)) * HTB)
#define PG8_SB(b, h) ((4 + (b) * 2 + (h)) * HTB)
#define PG8_STAGE(bufoff, gbase, voff) do { _Pragma("unroll") for (int _i = 0; _i < 2; ++_i) \
        __builtin_amdgcn_global_load_lds((const unsigned*)((const char*)(gbase) + (voff)[_i]), (PG8_LAS unsigned*)(lds + (bufoff) + ldsw + _i * 8192), 16, 0, 0); } while (0)
#define PG8_LDA(dst, b, h) do { _Pragma("unroll") for (int m = 0; m < 4; ++m) _Pragma("unroll") for (int k = 0; k < 2; ++k) dst[m][k] = *(const PG8_LAS bf16x8*)(lds + PG8_SA(b, h) + aoff + m * 2048 + k * 1024); } while (0)
#define PG8_LDB(dst, b, h) do { _Pragma("unroll") for (int n = 0; n < 2; ++n) _Pragma("unroll") for (int k = 0; k < 2; ++k) dst[n][k] = *(const PG8_LAS bf16x8*)(lds + PG8_SB(b, h) + boff + n * 2048 + k * 1024); } while (0)
#define PG8_MMA(ai, bj, At, Bt) do { __builtin_amdgcn_s_setprio(1); _Pragma("unroll") for (int m = 0; m < 4; ++m) _Pragma("unroll") for (int n = 0; n < 2; ++n) _Pragma("unroll") for (int k = 0; k < 2; ++k) \
        acc[ai][bj][m][n] = __builtin_amdgcn_mfma_f32_16x16x32_bf16(Bt[n][k], At[m][k], acc[ai][bj][m][n], 0, 0, 0); __builtin_amdgcn_s_setprio(0); } while (0)
#define PG8_WAIT_V(n) asm volatile("s_waitcnt vmcnt(" #n ")" ::: "memory")
#define PG8_WAIT_L(n) asm volatile("s_waitcnt lgkmcnt(" #n ")" ::: "memory")
#define PG8_BAR __builtin_amdgcn_s_barrier()
#define PG8_SCHED __builtin_amdgcn_sched_barrier(0)
    Unit cur, nxt; int ui = 0;
    if (!S.next(0, cur)) return;
    f32x4 acc[2][2][4][2];
#pragma unroll
    for (int a = 0; a < 2; ++a)
#pragma unroll
        for (int b = 0; b < 2; ++b)
#pragma unroll
            for (int m = 0; m < 4; ++m)
#pragma unroll
                for (int n = 0; n < 2; ++n) acc[a][b][m][n] = (f32x4){0.f, 0.f, 0.f, 0.f};
    bf16x8 At[4][2], B0[2][2], B1[2][2];
    const char* cA = (const char*)g.A + (size_t)cur.pm * tstep; const char* cB = (const char*)g.Bt + (size_t)cur.pn * tstep;
    S.a_ready(cur);
    if constexpr (SP2) {
        PG8_STAGE(PG8_SB(0, 0), cB, voffB); PG8_STAGE(PG8_SB(0, 1), cB + hstep, voffB); PG8_STAGE(PG8_SA(0, 0), cA, voffA); PG8_STAGE(PG8_SA(0, 1), cA + hstep, voffA);
        if (wr == 1) PG8_BAR;
        PG8_WAIT_V(2); PG8_BAR;
        PG8_STAGE(PG8_SB(1, 0), cB + kstep, voffB); PG8_STAGE(PG8_SA(1, 0), cA + kstep, voffA); PG8_STAGE(PG8_SB(1, 1), cB + hstep + kstep, voffB);
        PG8_WAIT_V(6); PG8_BAR;
    } else {
        PG8_STAGE(PG8_SB(0, 0), cB, voffB); PG8_STAGE(PG8_SA(0, 0), cA, voffA); PG8_STAGE(PG8_SB(0, 1), cB + hstep, voffB); PG8_STAGE(PG8_SA(0, 1), cA + hstep, voffA);
        if (wr == 1) PG8_BAR;
        PG8_WAIT_V(4); PG8_BAR;
        PG8_STAGE(PG8_SB(1, 0), cB + kstep, voffB); PG8_STAGE(PG8_SA(1, 0), cA + kstep, voffA); PG8_STAGE(PG8_SB(1, 1), cB + hstep + kstep, voffB);
        PG8_WAIT_V(6); PG8_BAR;
    }
    for (;;) {
        const bool has_next = S.next(ui + 1, nxt);
        const char* nA = has_next ? (const char*)g.A + (size_t)nxt.pm * tstep : cA; const char* nB = has_next ? (const char*)g.Bt + (size_t)nxt.pn * tstep : cB;
        for (int t = 0; t < nt; t += 2) {
            if constexpr (Epi::HAS_MIDK) { if (t == E.midk_t) E.midk(acc, cur, wr, wc, fr, fq); }
            const bool last = (t == nt - 2);
            const char* a1 = cA + (size_t)(t + 1) * kstep;
            const char* a2 = last ? nA : cA + (size_t)(t + 2) * kstep; const char* b2 = last ? nB : cB + (size_t)(t + 2) * kstep;
            const char* a3 = a2 + kstep; const char* b3 = b2 + kstep;
            if (last && has_next) S.a_ready(nxt);
            if constexpr (SP2) {
            PG8_LDB(B0, 0, 0); PG8_LDB(B1, 0, 1); PG8_SCHED; PG8_LDA(At, 0, 0); PG8_STAGE(PG8_SA(1, 1), a1 + hstep, voffA);
            PG8_WAIT_V(8); PG8_WAIT_L(0); PG8_BAR; PG8_MMA(0, 0, At, B0); PG8_MMA(0, 1, At, B1); PG8_BAR; PG8_SCHED;
            PG8_LDA(At, 0, 1); PG8_STAGE(PG8_SB(0, 0), b2, voffB); PG8_STAGE(PG8_SB(0, 1), b2 + hstep, voffB); PG8_STAGE(PG8_SA(0, 0), a2, voffA);
            PG8_WAIT_V(8); PG8_WAIT_L(0); PG8_BAR; PG8_MMA(1, 0, At, B0); PG8_MMA(1, 1, At, B1); PG8_BAR; PG8_SCHED;
            PG8_LDB(B0, 1, 0); PG8_LDB(B1, 1, 1); PG8_SCHED; PG8_LDA(At, 1, 0); PG8_STAGE(PG8_SA(0, 1), a2 + hstep, voffA);
            PG8_WAIT_V(8); PG8_WAIT_L(0); PG8_BAR; PG8_MMA(0, 0, At, B0); PG8_MMA(0, 1, At, B1); PG8_BAR; PG8_SCHED;
            PG8_LDA(At, 1, 1); PG8_STAGE(PG8_SB(1, 0), b3, voffB); PG8_STAGE(PG8_SB(1, 1), b3 + hstep, voffB); PG8_STAGE(PG8_SA(1, 0), a3, voffA);
            PG8_WAIT_V(8); PG8_WAIT_L(0); PG8_BAR; PG8_MMA(1, 0, At, B0); PG8_MMA(1, 1, At, B1); PG8_BAR; PG8_SCHED;
            } else {
            PG8_LDB(B0, 0, 0); PG8_SCHED; PG8_LDA(At, 0, 0); PG8_STAGE(PG8_SA(1, 1), a1 + hstep, voffA);
            PG8_WAIT_L(8); PG8_BAR; PG8_WAIT_L(0); PG8_MMA(0, 0, At, B0); PG8_BAR; PG8_SCHED;
            PG8_LDB(B1, 0, 1); PG8_STAGE(PG8_SB(0, 0), b2, voffB);
            PG8_BAR; PG8_WAIT_L(0); PG8_MMA(0, 1, At, B1); PG8_BAR;
            PG8_LDA(At, 0, 1); PG8_STAGE(PG8_SA(0, 0), a2, voffA);
            PG8_BAR; PG8_WAIT_L(0); PG8_MMA(1, 0, At, B0); PG8_BAR; PG8_SCHED;
            PG8_STAGE(PG8_SB(0, 1), b2 + hstep, voffB);
            PG8_WAIT_V(6); PG8_BAR; PG8_MMA(1, 1, At, B1); PG8_BAR;
            PG8_LDB(B0, 1, 0); PG8_SCHED; PG8_LDA(At, 1, 0); PG8_STAGE(PG8_SA(0, 1), a2 + hstep, voffA);
            PG8_WAIT_L(8); PG8_BAR; PG8_WAIT_L(0); PG8_MMA(0, 0, At, B0); PG8_BAR; PG8_SCHED;
            PG8_LDB(B1, 1, 1); PG8_STAGE(PG8_SB(1, 0), b3, voffB);
            PG8_BAR; PG8_WAIT_L(0); PG8_MMA(0, 1, At, B1); PG8_BAR;
            PG8_LDA(At, 1, 1); PG8_STAGE(PG8_SA(1, 0), a3, voffA);
            PG8_BAR; PG8_WAIT_L(0); PG8_MMA(1, 0, At, B0); PG8_BAR; PG8_SCHED;
            PG8_STAGE(PG8_SB(1, 1), b3 + hstep, voffB);
            PG8_WAIT_V(6); PG8_BAR; PG8_MMA(1, 1, At, B1); PG8_BAR;
            }
        }
        if constexpr (ALIGN_EPI) { if (wr == 0) PG8_BAR; }
        if constexpr (!Epi::AFTER_DRAIN) { E(acc, cur, wr, wc, fr, fq); S.done(cur); }
        if (!has_next) break;
#pragma unroll
        for (int a = 0; a < 2; ++a)
#pragma unroll
            for (int b = 0; b < 2; ++b)
#pragma unroll
                for (int m = 0; m < 4; ++m)
#pragma unroll
                    for (int n = 0; n < 2; ++n) acc[a][b][m][n] = (f32x4){0.f, 0.f, 0.f, 0.f};
        cur = nxt; cA = nA; cB = nB; ++ui;
        if constexpr (ALIGN_EPI) { if (wr == 1) PG8_BAR; }
    }
    PG8_WAIT_V(0);
    if constexpr (!ALIGN_EPI) { if (wr == 0) PG8_BAR; }
    PG8_BAR;
    if constexpr (Epi::AFTER_DRAIN) { E.fused(acc, cur, wr, wc, fr, fq, lds, wid, lane); S.done(cur); }
#undef PG8_SA
#undef PG8_SB
#undef PG8_STAGE
#undef PG8_LDA
#undef PG8_LDB
#undef PG8_MMA
#undef PG8_WAIT_V
#undef PG8_WAIT_L
#undef PG8_BAR
#undef PG8_SCHED
}
}
#define LAS __attribute__((address_space(3)))
typedef unsigned short bf16;
typedef float f32x4 __attribute__((ext_vector_type(4)));
typedef float f32x2v __attribute__((ext_vector_type(2)));
typedef float f32x16 __attribute__((ext_vector_type(16)));
typedef unsigned v4u __attribute__((ext_vector_type(4)));
typedef unsigned v2u __attribute__((ext_vector_type(2)));
typedef short bf16x8 __attribute__((ext_vector_type(8)));
using pg8::cvt_pk_bf16;
__device__ __forceinline__ float bflo(unsigned w) { return __uint_as_float(w << 16); }
__device__ __forceinline__ float bfhi(unsigned w) { return __uint_as_float(w & 0xffff0000u); }
__device__ __forceinline__ float wave_sum(float v) {
#pragma unroll
    for (int o = 1; o < 64; o <<= 1) v += __shfl_xor(v, o);
    return v;
}

constexpr int VT_STR = 144;
template <int DQK, bool ROPEQ, bool VTR>
__device__ __forceinline__ void attn_unit(LAS unsigned char* lds,
        const bf16* Qb, long q_pitch, const bf16* Kb, long k_pitch, const bf16* Kpe, long kpe_pitch, const bf16* Vb, long v_pitch,
        bf16* Ob, long o_pitch, float* lse, long lse_pitch, int q0, int W, float sc2, float slope2, const f32x2v* rope, const int tid_in) {
    constexpr int KSTR = DQK * 2 + 16;
    constexpr int ND0 = DQK / 16;
    LAS unsigned char* Kt = lds;
    LAS unsigned char* Vt = lds + 64 * KSTR;
    int tid_ = tid_in; asm volatile("" : "+v"(tid_));
    const int tid = tid_, lane = tid & 63, r32 = lane & 31, hi = lane >> 5; const int wid = __builtin_amdgcn_readfirstlane(tid >> 6);
    const int qlo = q0 + 32 * wid, qrow = qlo + r32;
    bf16x8 qf[ND0];
    { const bf16* qp = Qb + (long)qrow * q_pitch + 8 * hi;
#pragma unroll
      for (int d0 = 0; d0 < ND0; ++d0) qf[d0] = *(const bf16x8*)(qp + 16 * d0); }
    if constexpr (ROPEQ) {
#pragma unroll
        for (int dp = 0; dp < 2; ++dp) {
            const f32x2v* rp = rope + (long)qrow * 32 + 16 * dp + 8 * hi;
            bf16x8 x1 = qf[8 + dp], x2 = qf[10 + dp]; bf16x8 y1, y2;
#pragma unroll
            for (int j = 0; j < 8; j += 2) {
                const f32x2v cs0 = rp[j], cs1 = rp[j + 1];
                const float a0 = __uint_as_float(((unsigned)(unsigned short)x1[j]) << 16), a1 = __uint_as_float(((unsigned)(unsigned short)x1[j + 1]) << 16);
                const float b0 = __uint_as_float(((unsigned)(unsigned short)x2[j]) << 16), b1 = __uint_as_float(((unsigned)(unsigned short)x2[j + 1]) << 16);
                const unsigned w1 = cvt_pk_bf16(a0 * cs0.x - b0 * cs0.y, a1 * cs1.x - b1 * cs1.y);
                const unsigned w2 = cvt_pk_bf16(b0 * cs0.x + a0 * cs0.y, b1 * cs1.x + a1 * cs1.y);
                y1[j] = (short)(w1 & 0xffffu); y1[j + 1] = (short)(w1 >> 16); y2[j] = (short)(w2 & 0xffffu); y2[j + 1] = (short)(w2 >> 16);
            }
            qf[8 + dp] = y1; qf[10 + dp] = y2;
        }
    }
    f32x16 o[4];
#pragma unroll
    for (int i = 0; i < 4; ++i) o[i] = f32x16{};
    float m_run = -1e30f, l_run = 0.f;
    const int kt_hi = (q0 >> 6) + 3; int kt_lo = (q0 - W) >> 6; if (kt_lo < 0) kt_lo = 0;
    const int kr0 = tid >> 4, kc0 = tid & 15;
    const int pr = tid >> 3, pc = tid & 7;
    const int vc0 = wid, vc1 = wid + 8;
    v4u kreg0, kreg1, preg = (v4u){0u, 0u, 0u, 0u}, vreg0, vreg1;
    const unsigned koff0 = (unsigned)((kr0 * k_pitch + 8 * kc0) * 2), koff1 = (unsigned)(((kr0 + 32) * k_pitch + 8 * kc0) * 2), poff = (unsigned)((pr * kpe_pitch + 8 * pc) * 2);
    const unsigned voff0 = VTR ? (unsigned)(((tid >> 3) * v_pitch + (tid & 7) * 8) * 2) : (unsigned)((lane * v_pitch + 8 * vc0) * 2), voff1 = VTR ? voff0 + (unsigned)(64 * v_pitch * 2) : voff0 + 128u;
#define ATT_LOAD(kt) do { const char* kb_ = (const char*)Kb + (size_t)(kt) * 128 * (size_t)k_pitch; const char* vb_ = (const char*)Vb + (VTR ? (size_t)(kt) * 128 : (size_t)(kt) * 128 * (size_t)v_pitch); \
        kreg0 = *(const v4u*)(kb_ + koff0); kreg1 = *(const v4u*)(kb_ + koff1); \
        if constexpr (DQK == 192) { const char* pb_ = (const char*)Kpe + (size_t)(kt) * 128 * (size_t)kpe_pitch; preg = *(const v4u*)(pb_ + poff); } \
        vreg0 = *(const v4u*)(vb_ + voff0); vreg1 = *(const v4u*)(vb_ + voff1); } while (0)
    constexpr int TILE_BYTES = 64 * KSTR + 128 * VT_STR;
    const int pir = (r32 & ~12) | ((r32 & 4) << 1) | ((r32 & 8) >> 1);
    const LAS unsigned char* kread0 = Kt + pir * KSTR + hi * 16;
    const LAS unsigned char* vread0 = Vt + r32 * VT_STR + hi * 16;
#define ATT_STAGE(boff) do { LAS unsigned char* kt_ = Kt + (boff); LAS unsigned char* vt_ = Vt + (boff); \
        *(LAS v4u*)(kt_ + kr0 * KSTR + kc0 * 16) = kreg0; *(LAS v4u*)(kt_ + (kr0 + 32) * KSTR + kc0 * 16) = kreg1; \
        if constexpr (DQK == 192) *(LAS v4u*)(kt_ + pr * KSTR + 256 + pc * 16) = preg; \
        if constexpr (VTR) { *(LAS v4u*)(vt_ + (tid >> 3) * VT_STR + (tid & 7) * 16) = vreg0; *(LAS v4u*)(vt_ + ((tid >> 3) + 64) * VT_STR + (tid & 7) * 16) = vreg1; } \
        else { LAS unsigned short* v0p = (LAS unsigned short*)(vt_ + (8 * vc0) * VT_STR + lane * 2); LAS unsigned short* v1p = (LAS unsigned short*)(vt_ + (8 * vc1) * VT_STR + lane * 2); \
            _Pragma("unroll") for (int j = 0; j < 4; ++j) { \
                v0p[(2 * j) * (VT_STR / 2)] = (unsigned short)(vreg0[j] & 0xffffu); v0p[(2 * j + 1) * (VT_STR / 2)] = (unsigned short)(vreg0[j] >> 16); \
                v1p[(2 * j) * (VT_STR / 2)] = (unsigned short)(vreg1[j] & 0xffffu); v1p[(2 * j + 1) * (VT_STR / 2)] = (unsigned short)(vreg1[j] >> 16); } } } while (0)
    ATT_LOAD(kt_lo);
    __syncthreads();
    ATT_STAGE(0);
    if (kt_lo < kt_hi) ATT_LOAD(kt_lo + 1);
    __syncthreads();
#pragma unroll 1
    for (int kt = kt_lo; kt <= kt_hi; ++kt) {
        const int boff = ((kt - kt_lo) & 1) * TILE_BYTES;
        const LAS unsigned char* kread = kread0 + boff; const LAS unsigned char* vread = vread0 + boff;
        const int k0 = kt * 64;
        if (!(k0 > qlo + 31 || k0 + 63 < qlo - W)) {
        f32x16 p0 = f32x16{}, p1 = f32x16{};
#pragma unroll
        for (int d0 = 0; d0 < ND0; ++d0) {
            const bf16x8 a0 = *(const LAS bf16x8*)(kread + d0 * 32), a1 = *(const LAS bf16x8*)(kread + 32 * KSTR + d0 * 32);
            p0 = __builtin_amdgcn_mfma_f32_32x32x16_bf16(a0, qf[d0], p0, 0, 0, 0);
            p1 = __builtin_amdgcn_mfma_f32_32x32x16_bf16(a1, qf[d0], p1, 0, 0, 0);
        }
        const bool need_mask = (k0 + 63 > qlo) || (k0 < qlo + 31 - W);
        const int dbase = qrow - k0 - 8 * hi;
        float mx = -INFINITY;
        if (slope2 != 0.f) {
            const float sr = slope2 / sc2, b0 = -sr * (float)dbase;
#pragma unroll
            for (int r = 0; r < 16; ++r) { const float c = (float)(16 * (r >> 3) + (r & 7)); p0[r] += __builtin_fmaf(sr, c, b0); p1[r] += __builtin_fmaf(sr, c + 32.0f, b0); }
        }
        if (need_mask) {
#pragma unroll
            for (int r = 0; r < 16; ++r) { const int c = 16 * (r >> 3) + (r & 7);
                if ((unsigned)(dbase - c) > (unsigned)W) p0[r] = -INFINITY;
                if ((unsigned)(dbase - c - 32) > (unsigned)W) p1[r] = -INFINITY; }
        }
#pragma unroll
        for (int r = 0; r < 16; r += 2) mx = fmaxf(mx, fmaxf(fmaxf(p0[r], p0[r + 1]), fmaxf(p1[r], p1[r + 1])));
        mx = fmaxf(mx, __shfl_xor(mx, 32)) * sc2;
        const float m_new = fmaxf(m_run, mx), alpha = __builtin_amdgcn_exp2f(m_run - m_new);
        m_run = m_new;
        float rs = 0.f;
#pragma unroll
        for (int r = 0; r < 16; ++r) { p0[r] = __builtin_amdgcn_exp2f(__builtin_fmaf(p0[r], sc2, -m_new)); p1[r] = __builtin_amdgcn_exp2f(__builtin_fmaf(p1[r], sc2, -m_new)); rs += p0[r] + p1[r]; }
        l_run = l_run * alpha + rs;
#pragma unroll
        for (int i = 0; i < 4; ++i)
#pragma unroll
            for (int r = 0; r < 16; ++r) o[i][r] *= alpha;
        bf16x8 pf[4];
#pragma unroll
        for (int s = 0; s < 2; ++s) {
            v4u w0, w1;
            w0.x = cvt_pk_bf16(p0[8 * s + 0], p0[8 * s + 1]); w0.y = cvt_pk_bf16(p0[8 * s + 2], p0[8 * s + 3]); w0.z = cvt_pk_bf16(p0[8 * s + 4], p0[8 * s + 5]); w0.w = cvt_pk_bf16(p0[8 * s + 6], p0[8 * s + 7]);
            w1.x = cvt_pk_bf16(p1[8 * s + 0], p1[8 * s + 1]); w1.y = cvt_pk_bf16(p1[8 * s + 2], p1[8 * s + 3]); w1.z = cvt_pk_bf16(p1[8 * s + 4], p1[8 * s + 5]); w1.w = cvt_pk_bf16(p1[8 * s + 6], p1[8 * s + 7]);
            pf[s] = __builtin_bit_cast(bf16x8, w0); pf[2 + s] = __builtin_bit_cast(bf16x8, w1);
        }
#pragma unroll
        for (int db = 0; db < 4; ++db)
#pragma unroll
            for (int s = 0; s < 4; ++s) {
                const bf16x8 vf = *(const LAS bf16x8*)(vread + db * 32 * VT_STR + s * 32);
                o[db] = __builtin_amdgcn_mfma_f32_32x32x16_bf16(vf, pf[s], o[db], 0, 0, 0);
            }
        }
        if (kt < kt_hi) { ATT_STAGE(TILE_BYTES - boff); if (kt + 1 < kt_hi) ATT_LOAD(kt + 2); }
        __syncthreads();
    }
#undef ATT_LOAD
#undef ATT_STAGE
    const float l_tot = l_run + __shfl_xor(l_run, 32), inv = 1.0f / l_tot;
    bf16* op = Ob + (long)qrow * o_pitch + 4 * hi;
#pragma unroll
    for (int db = 0; db < 4; ++db)
#pragma unroll
        for (int g = 0; g < 4; ++g) { v2u w; w.x = cvt_pk_bf16(o[db][4 * g] * inv, o[db][4 * g + 1] * inv); w.y = cvt_pk_bf16(o[db][4 * g + 2] * inv, o[db][4 * g + 3] * inv);
            *(v2u*)(op + 32 * db + 8 * g) = w; }
    if (lse != nullptr && hi == 0) lse[(long)qrow * lse_pitch] = (m_run + __builtin_amdgcn_logf(l_tot)) * 0.6931471805599453f;
}
constexpr int T = 16384, SEQ = 4096, DM = 2048, DFF = 5504, NUP = 2 * DFF;
constexpr int N_IN_PAD = 9728;
constexpr int UP_TILES_A = 24, UP_TILES_B = 19;
constexpr size_t MiB = 1u << 20;
constexpr size_t WS_RSTD0 = 0, WS_SSQQ = 65536, WS_SSQKV = 2 * 65536, WS_SSQ1 = 3 * 65536, WS_SSQ2 = 4 * 65536;
constexpr size_t WS_LSE = 1 * MiB;
constexpr size_t WS_ROPE = 2 * MiB;
constexpr size_t WS_WUQ = 3 * MiB;
constexpr size_t WS_WKV = WS_WUQ + 1536 * 512 * 2;
constexpr size_t WS_WOM = WS_WKV + 2048 * 256 * 2;
constexpr size_t WS_WOD = WS_WOM + 2048 * 1024 * 2;
constexpr size_t WS_WOUT = WS_WOD + 2048 * 512 * 2;
constexpr size_t WS_A = 19 * MiB + 512 * 1024;
constexpr size_t WS_C = 83 * MiB + 512 * 1024;
constexpr size_t WS_WIN = WS_C, WS_V = WS_C;
constexpr size_t WS_CQ = 122 * MiB, WS_CKV = 138 * MiB, WS_KPER = 146 * MiB;
constexpr size_t WS_WDN = WS_C, WS_WUP = WS_WDN + (size_t)DM * DFF * 2;
constexpr size_t WS_E = 150 * MiB;
constexpr size_t WS_DQ = WS_E, WS_DK = WS_E + 48 * MiB, WS_DV = WS_E + 96 * MiB;
constexpr size_t WS_ATT = WS_E, WS_DIL = WS_E + 32 * MiB;
constexpr size_t WS_GA = 294 * MiB, WS_GB = 358 * MiB;
constexpr size_t WS_G = 422 * MiB;
constexpr size_t WS_Q = WS_G, WS_KN = WS_G + 48 * MiB, WS_KPE = WS_G + 80 * MiB, WS_MERGEB = WS_G;
constexpr size_t WS_U = 148 * MiB;
constexpr size_t WS_ACT = 340 * MiB;
constexpr size_t WS_END = 512 * MiB;
static_assert(WS_WOUT + (size_t)DM * DM * 2 <= WS_A && WS_A + 64 * MiB <= WS_C && WS_C + 38 * MiB <= WS_CQ, "small weights / A / C");
static_assert(WS_WUP + (size_t)NUP * DM * 2 <= WS_U, "wup");
static_assert((size_t)T * UP_TILES_A * 256 * 2 == 192 * MiB, "U");
constexpr size_t WS_ACT_REAL = WS_U + 192 * MiB;
static_assert(WS_ACT_REAL + (size_t)T * DFF * 2 <= WS_END, "ACT must fit");

struct Args { const float* in[17]; float* out; unsigned char* ws; int ph_lo, ph_hi, coop, pad; };

__device__ __forceinline__ int map_row(int code, int n) {
    switch (code) {
        case 1: return n < 832 ? n : n + 192;
        case 2: { const int h = n >> 8, j = n & 255; return j < 128 ? h * 128 + j : 1024 + h * 128 + (j - 128); }
        case 3: { const int gate = n >= DFF ? 1 : 0, c = n - gate * DFF; return (c >> 7) * 256 + gate * 128 + (c & 127); }
        default: return n;
    }
}
__device__ __forceinline__ void conv_item(const float* W, int K, int N, bf16* WT, int ldk, int kofs, const float* g, int code, LAS float* scr, int item, int lane) {
    const int nblk = N / 32, kb = item / nblk, nb = item % nblk, k0 = 64 * kb, n0 = 32 * nb;
    const int drow0 = map_row(code, n0);
    const int c = lane & 7;
    f32x4 g0 = (f32x4){1.f, 1.f, 1.f, 1.f}, g1 = g0;
    if (g) { g0 = *(const f32x4*)(g + k0 + 8 * c); g1 = *(const f32x4*)(g + k0 + 8 * c + 4); }
    { float wv[32]; const float* wp = W + (size_t)(k0 + (lane >> 5)) * N + n0 + (lane & 31);
#pragma unroll
      for (int i = 0; i < 32; ++i) wv[i] = wp[(size_t)(2 * i) * N];
#pragma unroll
      for (int i = 0; i < 32; ++i) { const int kk = 2 * i + (lane >> 5); scr[kk * 33 + (lane & 31)] = wv[i]; } }
    asm volatile("s_waitcnt lgkmcnt(0)" ::: "memory");
#pragma unroll
    for (int j = 0; j < 4; ++j) { const int n = (lane >> 3) + 8 * j; const LAS float* s = scr + (8 * c) * 33 + n;
        v4u o; o.x = cvt_pk_bf16(s[0 * 33] * g0[0], s[1 * 33] * g0[1]); o.y = cvt_pk_bf16(s[2 * 33] * g0[2], s[3 * 33] * g0[3]); o.z = cvt_pk_bf16(s[4 * 33] * g1[0], s[5 * 33] * g1[1]); o.w = cvt_pk_bf16(s[6 * 33] * g1[2], s[7 * 33] * g1[3]);
        *(v4u*)(WT + (size_t)(drow0 + n) * ldk + kofs + k0 + 8 * c) = o; }
    asm volatile("s_waitcnt lgkmcnt(0)" ::: "memory");
}
__device__ __forceinline__ void conv_matrix(const float* W, int K, int N, bf16* WT, int ldk, int kofs, const float* g, int code, LAS float* scr, int gw, int NGW, int lane) {
    const int nitems = (K / 64) * (N / 32);
    for (int it = gw; it < nitems; it += NGW) conv_item(W, K, N, WT, ldk, kofs, g, code, scr, it, lane);
}
__device__ __forceinline__ void conv_matrix_wg(const float* W, int K, int N, bf16* WT, int ldk, int kofs, const float* g, int code, LAS unsigned char* lds, int bid, int G, int tid, int& rot) {
    const int nblk = (N + 255) / 256, nitems = (K / 64) * nblk;
    const int lane = tid & 63, w = tid >> 6, c = tid & 7;
    int first = bid - rot; if (first < 0) first += G;
    for (int it = first; it < nitems; it += 2 * G) {
        const int it2 = it + G; const bool two = it2 < nitems;
        float v[2][32]; int k0s[2], n0s[2];
#pragma unroll
        for (int q = 0; q < 2; ++q) {
            const int iq = q == 0 ? it : (two ? it2 : it);
            const int kb = iq / nblk, nb = iq - kb * nblk; k0s[q] = 64 * kb; n0s[q] = 256 * nb;
            const float* wp = W + (size_t)(k0s[q] + 8 * w) * N + n0s[q] + lane;
            if (q == 0 || two) {
#pragma unroll
                for (int i = 0; i < 8; ++i)
#pragma unroll
                    for (int e = 0; e < 4; ++e) v[q][i * 4 + e] = (n0s[q] + lane + 64 * e < N) ? wp[(size_t)i * N + 64 * e] : 0.f;
            }
        }
        __syncthreads();
#pragma unroll
        for (int q = 0; q < 2; ++q) { LAS float* Tt = (LAS float*)lds + q * (64 * 257);
            if (q == 0 || two) {
#pragma unroll
                for (int i = 0; i < 8; ++i)
#pragma unroll
                    for (int e = 0; e < 4; ++e) Tt[(8 * w + i) * 257 + lane + 64 * e] = v[q][i * 4 + e];
            } }
        __syncthreads();
#pragma unroll
        for (int q = 0; q < 2; ++q) { const LAS float* Tt = (const LAS float*)lds + q * (64 * 257);
            if (q == 0 || two) {
                const int k0 = k0s[q], n0 = n0s[q];
                f32x4 g0 = (f32x4){1.f, 1.f, 1.f, 1.f}, g1 = g0;
                if (g) { g0 = *(const f32x4*)(g + k0 + 8 * c); g1 = *(const f32x4*)(g + k0 + 8 * c + 4); }
#pragma unroll
                for (int j = 0; j < 4; ++j) { const int n = (tid >> 3) + 64 * j;
                    if (n0 + n < N) { const LAS float* s = Tt + (8 * c) * 257 + n; const int drow = map_row(code, n0 + n);
                        v4u o; o.x = cvt_pk_bf16(s[0 * 257] * g0[0], s[1 * 257] * g0[1]); o.y = cvt_pk_bf16(s[2 * 257] * g0[2], s[3 * 257] * g0[3]); o.z = cvt_pk_bf16(s[4 * 257] * g1[0], s[5 * 257] * g1[1]); o.w = cvt_pk_bf16(s[6 * 257] * g1[2], s[7 * 257] * g1[3]);
                        *(v4u*)(WT + (size_t)drow * ldk + kofs + k0 + 8 * c) = o; } }
            } }
    }
    rot = (rot + nitems) % G;
    __syncthreads();
}
__device__ __forceinline__ void row_to_bf16_rstd(const float* xrow, bf16* orow, float* rstd_out, int lane) {
    const f32x4* xr = (const f32x4*)xrow + lane; f32x4 v[8]; float s = 0.f;
#pragma unroll
    for (int j = 0; j < 8; ++j) { v[j] = xr[64 * j]; s += (v[j].x * v[j].x + v[j].y * v[j].y) + (v[j].z * v[j].z + v[j].w * v[j].w); }
    s = wave_sum(s);
    if (lane == 0) *rstd_out = rsqrtf(s * (1.0f / DM) + 1e-6f);
    v2u* o8 = (v2u*)orow + lane;
#pragma unroll
    for (int j = 0; j < 8; ++j) { v2u w; w.x = cvt_pk_bf16(v[j].x, v[j].y); w.y = cvt_pk_bf16(v[j].z, v[j].w); o8[64 * j] = w; }
}

#define XB_TMO      128
#define XB_XCNT(j)  (256  + 64 * (j))
#define XB_XSUB(j)  (1280 + 64 * (j))
#define XB_XGEN(j)  (2304 + 64 * (j))
#define XB_TOP      3328
#define XB_TOPGEN   3392
#define XCD_BAR_WORDS 3456
#define XB_SPIN_CAP (1u << 20)
__device__ __forceinline__ unsigned xb_ld(unsigned* p)              { return __hip_atomic_load(p, __ATOMIC_RELAXED, __HIP_MEMORY_SCOPE_AGENT); }
__device__ __forceinline__ unsigned xb_add(unsigned* p, unsigned v) { return __hip_atomic_fetch_add(p, v, __ATOMIC_RELAXED, __HIP_MEMORY_SCOPE_AGENT); }
__device__ __forceinline__ unsigned xb_xcc_id() { return (unsigned)__builtin_amdgcn_s_getreg((3 << 11) | 20) & 0xFu; }
#define XB_SPIN(cond, bar) do { unsigned _sp = 0; while (cond) { __builtin_amdgcn_s_sleep(1); \
    if ((++_sp & 255u) == 0u) { if (xb_ld(&(bar)[XB_TMO])) break; if (_sp > XB_SPIN_CAP) { atomicAdd(&(bar)[XB_TMO], 1u); break; } } } } while (0)
__device__ __forceinline__ void xcd_barrier_complete(unsigned* bar, unsigned x, unsigned G, unsigned& nloc, unsigned& nx) {
    unsigned sum, cnt, mine, sp = 0u;
    for (;;) {
        sum = 0u; cnt = 0u; mine = 0u;
#pragma unroll
        for (unsigned j = 0; j < 16; ++j) { const unsigned c = xb_ld(&bar[XB_XCNT(j)]); sum += c; cnt += (c > 0u) ? 1u : 0u; mine = (j == x) ? c : mine; }
        if (sum == G) break;
        __builtin_amdgcn_s_sleep(1);
        if ((++sp & 255u) == 0u) { if (xb_ld(&bar[XB_TMO])) break; if (sp > XB_SPIN_CAP) { atomicAdd(&bar[XB_TMO], 1u); break; } }
    }
    nloc = mine > 0u ? mine : 1u; nx = cnt > 0u ? cnt : 1u;
}
__device__ __forceinline__ void xcd_barrier(unsigned* bar, volatile LAS unsigned* st, unsigned G, bool leader) {
    asm volatile("s_waitcnt vmcnt(0)" ::: "memory");
    __syncthreads();
    if (leader) {
        const unsigned x = xb_xcc_id();
        __builtin_amdgcn_s_waitcnt(0);
        unsigned nloc = st[0], nx = st[1];
        if (nloc == 0u) { xcd_barrier_complete(bar, x, G, nloc, nx); st[0] = nloc; st[1] = nx; }
        const unsigned old = xb_add(&bar[XB_XSUB(x)], 1u);
        const unsigned gen = old / nloc;
        if (old + 1u == (gen + 1u) * nloc) {
            __builtin_amdgcn_fence(__ATOMIC_RELEASE, "agent");
            asm volatile("s_waitcnt vmcnt(0)" ::: "memory");
            const unsigned og = xb_add(&bar[XB_TOP], 1u);
            const unsigned tg = og / nx;
            if (og + 1u == (tg + 1u) * nx) xb_add(&bar[XB_TOPGEN], 1u);
            else XB_SPIN(xb_ld(&bar[XB_TOPGEN]) == tg, bar);
            __builtin_amdgcn_fence(__ATOMIC_ACQUIRE, "agent");
            xb_add(&bar[XB_XGEN(x)], 1u);
            asm volatile("s_waitcnt vmcnt(0)" ::: "memory");
        } else {
            XB_SPIN(xb_ld(&bar[XB_XGEN(x)]) == gen, bar);
            __builtin_amdgcn_fence(__ATOMIC_ACQUIRE, "agent");
            asm volatile("s_waitcnt vmcnt(0)" ::: "memory");
        }
    }
    __syncthreads();
}

__device__ __forceinline__ bool unit_of(int M, int N, int G, int c, int i, int& pm, int& pn) {
    const int nM = M / 256, nN = N / 256, nwg = nM * nN; const long L = (long)i * G + c; if (L >= nwg) return false;
    int wgid = (int)L; { const int q = nwg / 8, r = nwg % 8, xcd = wgid % 8, off = wgid / 8; wgid = (xcd < r ? xcd * (q + 1) : r * (q + 1) + (xcd - r) * q) + off; }
    const int nig = pg8::WGM * nN, gid = wgid / nig, fm = gid * pg8::WGM, gsz = (nM - fm) < pg8::WGM ? (nM - fm) : pg8::WGM;
    pm = fm + ((wgid % nig) % gsz); pn = (wgid % nig) / gsz; return true;
}
__device__ __forceinline__ int lane_id_fresh() { int l; asm volatile("v_mbcnt_lo_u32_b32 %0, -1, 0\n\tv_mbcnt_hi_u32_b32 %0, -1, %0" : "=v"(l)); return l; }

constexpr int LDS_BYTES = 147456;
__global__ void __launch_bounds__(512, 2) fwd_mega(Args args) {
    extern __shared__ __attribute__((aligned(16))) unsigned char lds_raw[];
    LAS unsigned char* lds = (LAS unsigned char*)lds_raw;
    cg::grid_group grid = cg::this_grid();
    const int G = gridDim.x, bid = blockIdx.x;
    const int wave0 = __builtin_amdgcn_readfirstlane((int)threadIdx.x >> 6);
#define MKTID() (wave0 * 64 + lane_id_fresh())
    unsigned* BARW = (unsigned*)(args.ws + 6 * 65536);
    volatile LAS unsigned* BARST = (volatile LAS unsigned*)(lds + 139264);
    if (threadIdx.x == 0) { BARST[0] = 0u; BARST[1] = 0u; if (args.coop) (void)xb_add(&BARW[XB_XCNT(xb_xcc_id())], 1u); }
    __syncthreads();
#define GBAR() xcd_barrier(BARW, BARST, (unsigned)G, MKTID() == 0)
    const int NGW = G * 8, NGT = G * 512;
#define FRESH() int tid = MKTID(); asm volatile("" : "+v"(tid)); const int lane = tid & 63; const int wave = __builtin_amdgcn_readfirstlane(tid >> 6); \
    const int gw = bid * 8 + wave; const int gt = bid * 512 + tid; LAS float* scr = (LAS float*)(lds + wave * 16384); (void)lane; (void)gw; (void)gt; (void)scr
    unsigned char* ws = args.ws;
    const float* x = args.in[0]; const float* attn_norm_g = args.in[1]; const float* w_in = args.in[2]; const float* b_gate = args.in[3];
    const float* q_norm_g = args.in[4]; const float* w_uq = args.in[5]; const float* kv_norm_g = args.in[6]; const float* w_ukv = args.in[7];
    const float* w_o_mla = args.in[8]; const float* w_o_dil = args.in[9]; const float* w_out = args.in[10]; const float* ffn_norm_g = args.in[11];
    const float* w_up = args.in[12]; const float* conv_w = args.in[13]; const float* conv_b = args.in[14]; const float* w_down = args.in[15]; const float* final_norm_g = args.in[16];
    float* out = args.out;
    float* RSTD0 = (float*)(ws + WS_RSTD0); float* SSQQ = (float*)(ws + WS_SSQQ); float* SSQKV = (float*)(ws + WS_SSQKV); float* SSQ1 = (float*)(ws + WS_SSQ1); float* SSQ2 = (float*)(ws + WS_SSQ2);
    float* LSE = (float*)(ws + WS_LSE); f32x2v* ROPE = (f32x2v*)(ws + WS_ROPE);
    bf16* WUQ = (bf16*)(ws + WS_WUQ); bf16* WKV = (bf16*)(ws + WS_WKV); bf16* WOM = (bf16*)(ws + WS_WOM); bf16* WOD = (bf16*)(ws + WS_WOD); bf16* WOUT = (bf16*)(ws + WS_WOUT);
    bf16* WIN = (bf16*)(ws + WS_WIN); bf16* WDN = (bf16*)(ws + WS_WDN); bf16* WUP = (bf16*)args.out;
    bf16* XB = (bf16*)(ws + WS_A); bf16* OG = (bf16*)(ws + WS_A); bf16* X1B = (bf16*)(ws + WS_A);
    bf16* CQ = (bf16*)(ws + WS_CQ); bf16* CKV = (bf16*)(ws + WS_CKV); float* KPER = (float*)(ws + WS_KPER);
    bf16* DQ = (bf16*)(ws + WS_DQ); bf16* DK = (bf16*)(ws + WS_DK); bf16* DV = (bf16*)(ws + WS_DV);
    bf16* ATT = (bf16*)(ws + WS_ATT); bf16* DIL = (bf16*)(ws + WS_DIL);
    bf16* GA = (bf16*)(ws + WS_GA); bf16* GB = (bf16*)(ws + WS_GB);
    bf16* Q = (bf16*)(ws + WS_Q); bf16* KN = (bf16*)(ws + WS_KN); bf16* KPE = (bf16*)(ws + WS_KPE); bf16* V = (bf16*)(ws + WS_V); bf16* MERGEB = (bf16*)(ws + WS_MERGEB);
    bf16* U = (bf16*)(ws + WS_U); bf16* ACT = (bf16*)(ws + WS_ACT_REAL); float* HEADB = (float*)(ws + WS_U); float* TAILB = (float*)(ws + WS_U + 8 * MiB);
    float* MERGE = out;
    float* X1 = (float*)(ws + 164 * MiB);

    const int lo = args.ph_lo, hi = args.ph_hi;
#define IN(k) (lo <= (k) && (k) < hi)
#ifndef PROBE_DUP
#define PROBE_DUP 0
#endif
#define NREP(k) (((PROBE_DUP >> (k)) & 1) + 1)
#define REPSYNC() do { if (rep && args.coop) GBAR(); } while (0)
#define SEAM(k) do { if (IN(k) && IN((k) + 1)) { if (args.coop) { if ((k) == 0 && args.pad == 0x7fffffff) grid.sync();     \
        GBAR(); } } } while (0)
    float* DUMMY = (float*)(ws + 5 * 65536);

    if (IN(0)) for (int rep = 0; rep < NREP(0); ++rep) { REPSYNC(); FRESH(); int rot = 0;
        conv_matrix_wg(w_in, DM, 9536, WIN, DM, 0, attn_norm_g, 1, lds, bid, G, tid, rot);
        if (G != 256) {
        conv_matrix_wg(w_uq, 512, 1536, WUQ, 512, 0, q_norm_g, 0, lds, bid, G, tid, rot);
        conv_matrix_wg(w_ukv, 256, 2048, WKV, 256, 0, kv_norm_g, 2, lds, bid, G, tid, rot);
        conv_matrix_wg(w_o_mla, 1024, 2048, WOM, 1536, 0, nullptr, 0, lds, bid, G, tid, rot);
        conv_matrix_wg(w_o_dil, 512, 2048, WOM, 1536, 1024, nullptr, 0, lds, bid, G, tid, rot);
        conv_matrix_wg(w_out, 2048, 2048, WOUT, DM, 0, nullptr, 0, lds, bid, G, tid, rot);
        }
        for (int m = gw; m < T; m += NGW) row_to_bf16_rstd(x + (size_t)m * DM, XB + (size_t)m * DM, RSTD0 + m, lane);
        for (int i = gt; i < 4 * T; i += NGT) SSQQ[i] = 0.f;
        if (G != 256) for (int i = gt; i < SEQ * 32; i += NGT) { const int pos = i >> 5, f = i & 31; const float inv_freq = powf(10000.0f, -(float)(2 * f) / 64.0f); const float ang = (float)pos * inv_freq;
            float sn, cs; sincosf(ang, &sn, &cs); ROPE[i] = (f32x2v){cs, sn}; }
    }
    SEAM(0);
    if (IN(1)) for (int rep = 0; rep < NREP(1); ++rep) { REPSYNC();
        pg8::Gemm g{XB, WIN, T, N_IN_PAD, DM}; pg8::StaticOrder S; S.init(T, N_IN_PAD, G, bid);
        pg8::EpiProj E{CQ, CKV, DQ, DK, DV, GA, GB, KPER, RSTD0, rep ? nullptr : SSQQ, rep ? nullptr : SSQKV, b_gate};
        pg8::gemm_phase<pg8::EpiProj, pg8::StaticOrder, true, true>(lds, g, S, E, MKTID());
        if (G == 256 && bid >= 128 && rep == 0) {
            FRESH(); int rot = 0;
            conv_matrix_wg(w_uq, 512, 1536, WUQ, 512, 0, q_norm_g, 0, lds, bid - 128, 128, tid, rot);
            conv_matrix_wg(w_ukv, 256, 2048, WKV, 256, 0, kv_norm_g, 2, lds, bid - 128, 128, tid, rot);
            conv_matrix_wg(w_o_mla, 1024, 2048, WOM, 1536, 0, nullptr, 0, lds, bid - 128, 128, tid, rot);
            conv_matrix_wg(w_o_dil, 512, 2048, WOM, 1536, 1024, nullptr, 0, lds, bid - 128, 128, tid, rot);
            conv_matrix_wg(w_out, 2048, 2048, WOUT, DM, 0, nullptr, 0, lds, bid - 128, 128, tid, rot);
            conv_matrix_wg(w_up, DM, NUP, WUP, DM, 0, ffn_norm_g, 3, lds, bid - 128, 128, tid, rot);
            for (int i = (bid - 128) * 512 + tid; i < SEQ * 32; i += 128 * 512) { const int pos = i >> 5, f = i & 31; const float inv_freq = powf(10000.0f, -(float)(2 * f) / 64.0f); const float ang = (float)pos * inv_freq;
                float sn, cs; sincosf(ang, &sn, &cs); ROPE[i] = (f32x2v){cs, sn}; }
        }
    }
    SEAM(1);
    if (IN(2)) for (int rep = 0; rep < NREP(2); ++rep) { REPSYNC();
        { pg8::Gemm g{CQ, WUQ, T, 1536, 512}; pg8::StaticOrder S; S.init(T, 1536, G, bid);
          pg8::EpiRowScale E{Q, Q, 1000, 1536, SSQQ, 1.0f / 512.0f};
          pg8::gemm_phase<pg8::EpiRowScale, pg8::StaticOrder, true, true>(lds, g, S, E, MKTID()); }
        { pg8::Gemm g{CKV, WKV, T, 1024, 256}; pg8::StaticOrder S; S.init(T, 1024, G, (bid + 128) % G);
          pg8::EpiRowScale E{KN, KN, 1000, 1024, SSQKV, 1.0f / 256.0f};
          pg8::gemm_phase<pg8::EpiRowScale, pg8::StaticOrder, true, true>(lds, g, S, E, MKTID()); }
        { pg8::Gemm g{WKV + 1024 * 256, CKV, 1024, T, 256}; pg8::StaticOrder S; S.init(1024, T, G, bid);
          pg8::EpiColScale E{V, T, SSQKV, 1.0f / 256.0f};
          pg8::gemm_phase<pg8::EpiColScale, pg8::StaticOrder, true, true>(lds, g, S, E, MKTID()); }
        FRESH();
        for (int i = gt; i < T * 32; i += NGT) { const int t = i >> 5, f = i & 31; const float x1 = KPER[(size_t)t * 64 + f], x2 = KPER[(size_t)t * 64 + 32 + f]; const f32x2v cs = ROPE[(t & (SEQ - 1)) * 32 + f];
            KPE[(size_t)t * 64 + f] = (bf16)(cvt_pk_bf16(x1 * cs.x - x2 * cs.y, 0.f) & 0xffffu); KPE[(size_t)t * 64 + 32 + f] = (bf16)(cvt_pk_bf16(x2 * cs.x + x1 * cs.y, 0.f) & 0xffffu); }
        for (int uid = bid; uid < 768; uid += G) {
            const int g = uid >> 8, rem = uid & 255, b = rem >> 6, hs = (rem >> 4) & 3, sub = rem & 15;
            const int dil = g == 0 ? 1 : (g == 1 ? 4 : 16), nblk = 16 / dil, r = sub / nblk, ublk = sub % nblk;
            const float slope = exp2f(-8.0f * (float)(g * 4 + hs + 1) / 12.0f);
            const size_t rowb = (size_t)b * SEQ + r; const int colb = g * 512 + hs * 128;
#ifndef SKIP_DIL
            attn_unit<128, false, false>(lds, DQ + rowb * 1536 + colb, (long)dil * 1536, DK + rowb * 1536 + colb, (long)dil * 1536, nullptr, 0, DV + rowb * 1536 + colb, (long)dil * 1536,
                OG + (size_t)g * T * 512 + rowb * 512 + hs * 128, (long)dil * 512, LSE + ((size_t)g * T + rowb) * 4 + hs, (long)dil * 4, ublk * 256, 128,
                0.08838834764831845f * 1.4426950408889634f, slope * (float)dil * 1.4426950408889634f, nullptr, MKTID());
#endif
        }
    }
    SEAM(2);
    if (IN(3)) for (int rep = 0; rep < NREP(3); ++rep) { REPSYNC();
        for (int it = bid; it < 256; it += G) {
            const int bh = it >> 3, s = it & 7, b = bh >> 3, h = bh & 7;
            const size_t rowb = (size_t)b * SEQ;
#pragma unroll 1
            for (int k = 0; k < 2; ++k) { const int qb = k == 0 ? 15 - s : s;
#ifndef SKIP_MLA
                attn_unit<192, true, true>(lds, Q + rowb * 1536 + h * 192, 1536, KN + rowb * 1024 + h * 128, 1024, KPE + rowb * 64, 64, V + (size_t)(h * 128) * T + rowb, T,
                    ATT + rowb * 1536 + h * 128, 1536, nullptr, 0, qb * 256, 1 << 24, 0.07216878364870322f * 1.4426950408889634f, 0.f, ROPE, MKTID());
#endif
            }
        }
        FRESH();
        for (int i = gt; i < T * 64; i += NGT) {
            const int t = i >> 6, hs = (i >> 4) & 3, c = i & 15;
            const float l0 = LSE[(size_t)t * 4 + hs], l1 = LSE[((size_t)T + t) * 4 + hs], l2 = LSE[((size_t)2 * T + t) * 4 + hs];
            const float mx = fmaxf(l0, fmaxf(l1, l2)); float e0 = __expf(l0 - mx), e1 = __expf(l1 - mx), e2 = __expf(l2 - mx); const float inv = 1.0f / (e0 + e1 + e2); e0 *= inv; e1 *= inv; e2 *= inv;
            const size_t off = (size_t)t * 512 + hs * 128 + c * 8;
            const v4u a = *(const v4u*)(OG + off), b2 = *(const v4u*)(OG + (size_t)T * 512 + off), c2 = *(const v4u*)(OG + (size_t)2 * T * 512 + off); v4u o;
#pragma unroll
            for (int j = 0; j < 4; ++j) o[j] = cvt_pk_bf16(e0 * bflo(a[j]) + e1 * bflo(b2[j]) + e2 * bflo(c2[j]), e0 * bfhi(a[j]) + e1 * bfhi(b2[j]) + e2 * bfhi(c2[j]));
            *(v4u*)(ATT + (size_t)t * 1536 + 1024 + hs * 128 + c * 8) = o;
        }
    }
    SEAM(3);
    if (IN(4)) for (int rep = 0; rep < NREP(4); ++rep) { REPSYNC();
#ifndef PROBE_CONV
#define PROBE_CONV 1
#endif
        for (int r2 = 0; r2 < PROBE_CONV; ++r2) { FRESH(); int rot = 0;
        if (G != 256) conv_matrix_wg(w_up, DM, NUP, WUP, DM, 0, ffn_norm_g, 3, lds, bid, G, tid, rot);
        if (G != 256) conv_matrix_wg(w_down, DFF, DM, WDN, DFF, 0, nullptr, 0, lds, bid, G, tid, rot); }
        __syncthreads();
        { pg8::Gemm g{ATT, WOM, T, DM, 1536}; pg8::StaticOrder S; S.init(T, DM, G, bid);
          pg8::EpiMerge E{GA, GB, MERGEB, 16};
          pg8::gemm_phase<pg8::EpiMerge, pg8::StaticOrder, true, true>(lds, g, S, E, MKTID()); }
    }
    SEAM(4);
    if (IN(5)) for (int rep = 0; rep < NREP(5); ++rep) { REPSYNC();
        pg8::Gemm g{MERGEB, WOUT, T, DM, DM}; pg8::StaticOrder S; S.init(T, DM, G, bid);
        pg8::EpiResid E{x, X1, X1B, rep ? DUMMY : SSQ1};
        pg8::gemm_phase<pg8::EpiResid, pg8::StaticOrder, true, true>(lds, g, S, E, MKTID());
    }
    SEAM(5);
    if (IN(6)) for (int rep = 0; rep < NREP(6); ++rep) { REPSYNC();
        pg8::Gemm g{X1B, WUP, T, NUP, DM}; pg8::StaticOrder S; S.init(T, NUP, G, bid);
        pg8::EpiConvAct E{ACT, SSQ1, conv_w, conv_b, HEADB, TAILB, lds + 131072};
        pg8::gemm_phase<pg8::EpiConvAct, pg8::StaticOrder, true, true>(lds, g, S, E, MKTID());
        if (G == 256 && bid >= 192 && rep == 0) {
            FRESH(); int rot = 0;
            conv_matrix_wg(w_down, DFF, DM, WDN, DFF, 0, nullptr, 0, lds, bid - 192, 64, tid, rot);
        }
    }
    SEAM(6);
    if (IN(10)) for (int rep = 0; rep < NREP(10); ++rep) { REPSYNC();
        pg8::Gemm g{ACT, WDN, T, DM, DFF}; pg8::StaticOrder S; S.init(T, DM, G, bid);
        { FRESH();
#pragma unroll 1
          for (int i = 0; i < 64; ++i) { int pm, pn_; if (!unit_of(T, DM, G, bid, i, pm, pn_)) break; if ((pm & 15) == 0) continue;
            const float* tl = TAILB + (size_t)(pm - 1) * 2 * NUP; const float* hd = HEADB + (size_t)pm * 2 * NUP;
            for (int c = tid; c < DFF; c += 512) {
                const int colu = (c >> 7) * 256 + (c & 127), colg = colu + 128;
                const float um2 = tl[colu], um1 = tl[NUP + colu], u0 = hd[colu], u1 = hd[NUP + colu];
                const float gm2 = tl[colg], gm1 = tl[NUP + colg], g0 = hd[colg], g1 = hd[NUP + colg];
                const float wu0 = conv_w[c], wu1 = conv_w[NUP + c], wu2 = conv_w[2 * NUP + c], bu = conv_b[c];
                const float wg0 = conv_w[DFF + c], wg1 = conv_w[NUP + DFF + c], wg2 = conv_w[2 * NUP + DFF + c], bg = conv_b[DFF + c];
                const float cu0 = bu + wu0 * um2 + wu1 * um1 + wu2 * u0, cu1 = bu + wu0 * um1 + wu1 * u0 + wu2 * u1;
                const float cg0 = bg + wg0 * gm2 + wg1 * gm1 + wg2 * g0, cg1 = bg + wg0 * gm1 + wg1 * g0 + wg2 * g1;
                ACT[(size_t)(pm * 256) * DFF + c] = (bf16)(cvt_pk_bf16(cu0 * cg0 * __builtin_amdgcn_rcpf(1.0f + __expf(-cg0)), 0.f) & 0xffffu);
                ACT[(size_t)(pm * 256 + 1) * DFF + c] = (bf16)(cvt_pk_bf16(cu1 * cg1 * __builtin_amdgcn_rcpf(1.0f + __expf(-cg1)), 0.f) & 0xffffu);
            } }
          asm volatile("s_waitcnt vmcnt(0)" ::: "memory"); __syncthreads(); }
        pg8::EpiResid E{X1, out, nullptr, rep ? DUMMY : SSQ2};
        pg8::gemm_phase<pg8::EpiResid, pg8::StaticOrder, true, true>(lds, g, S, E, MKTID());
    }
    SEAM(10);
    if (IN(11)) { FRESH();
        for (int m = gw; m < T; m += NGW) {
            const float rs = rsqrtf(SSQ2[m] * (1.0f / DM) + 1e-6f);
            f32x4* xr = (f32x4*)(out + (size_t)m * DM) + lane; const f32x4* gr = (const f32x4*)final_norm_g + lane;
#pragma unroll
            for (int j = 0; j < 8; ++j) { const f32x4 v = xr[64 * j]; const f32x4 gg = gr[64 * j]; xr[64 * j] = v * rs * gg; }
        }
    }
#undef IN
#undef SEAM
}

#ifndef MK_N_LAUNCHES
#define MK_N_LAUNCHES 1
#endif
extern "C" void kernel_launch(void* const* d_in, const int* in_sizes, int n_in, void* d_out, int out_size, void* d_ws, size_t ws_size, hipStream_t stream) {
    static int grid = 0;
    if (grid == 0) {
        int dev = 0, cus = 0, per_cu = 0;
        if (n_in != 17 || out_size != T * DM || ws_size < WS_END) { fprintf(stderr, "kernel_launch: unexpected shapes / workspace (%d inputs, out %d, ws %zu)\n", n_in, out_size, ws_size); grid = -1; return; }
        (void)hipGetDevice(&dev);
        (void)hipDeviceGetAttribute(&cus, hipDeviceAttributeMultiprocessorCount, dev);
        (void)hipFuncSetAttribute((const void*)fwd_mega, hipFuncAttributeMaxDynamicSharedMemorySize, LDS_BYTES);
        (void)hipOccupancyMaxActiveBlocksPerMultiprocessor(&per_cu, (const void*)fwd_mega, 512, LDS_BYTES);
        if (per_cu < 1) per_cu = 1;
        grid = cus * per_cu;
        if (grid % 8 != 0 || grid < 8) grid = -1;
    }
    if (grid < 0) return;
    Args a{};
    for (int i = 0; i < 17; ++i) a.in[i] = (const float*)d_in[i];
    a.out = (float*)d_out; a.ws = (unsigned char*)d_ws;
#if MK_N_LAUNCHES == 1
    a.ph_lo = 0; a.ph_hi = 12; a.coop = 1;
    (void)hipMemsetAsync((unsigned char*)d_ws + 6 * 65536, 0, XCD_BAR_WORDS * 4, stream);
    void* kargs[] = {&a};
    hipError_t e = hipLaunchCooperativeKernel((const void*)fwd_mega, dim3(grid), dim3(512), kargs, LDS_BYTES, stream);
    if (e != hipSuccess) fprintf(stderr, "cooperative launch failed: %s (grid %d)\n", hipGetErrorString(e), grid);
#else
    for (int p = 0; p < 12; ++p) { a.ph_lo = p; a.ph_hi = p + 1; a.coop = 0; hipLaunchKernelGGL(fwd_mega, dim3(grid), dim3(512), LDS_BYTES, stream, a); }
#endif
}
```
